# Optimizing an MI355X kernel written in HIP

```python
import jax, jax.numpy as jnp
from jax import lax
import numpy as np

D_MODEL = 2048
BATCH = 8
SEQ = 4096
DEPTH = 2

MIX_WIDTH = D_MODEL
MLA_HEADS = D_MODEL // 256
QK_NOPE_DIM = 128
QK_ROPE_DIM = 64
QK_HEAD_DIM = QK_NOPE_DIM + QK_ROPE_DIM
V_HEAD_DIM = 128
Q_LORA_RANK = 512
KV_LORA_RANK = 256
ATTN_WIDTH = MLA_HEADS * V_HEAD_DIM
GM_WIDTH = MIX_WIDTH - ATTN_WIDTH
GM_GROUPS = D_MODEL // 256
GM_GROUP_DIM = GM_WIDTH // GM_GROUPS
CHUNK = 128
D_FF = 128 * ((8 * D_MODEL // 3 + 127) // 128)
PLE_DIM = 256
ROPE_BASE = 10000.0
EPS = 1e-6
Q_BLOCK = 128
IN_COLS = Q_LORA_RANK + KV_LORA_RANK + QK_ROPE_DIM + 2 * GM_WIDTH
SPLITS = (Q_LORA_RANK,
          Q_LORA_RANK + KV_LORA_RANK,
          Q_LORA_RANK + KV_LORA_RANK + QK_ROPE_DIM,
          Q_LORA_RANK + KV_LORA_RANK + QK_ROPE_DIM + GM_WIDTH)

kernel_name = "hybrid_mla_gmlp_macaron_ple"


def rms_norm(x, g):
    xf = x.astype(jnp.float32)
    y = xf * lax.rsqrt(jnp.mean(xf * xf, axis=-1, keepdims=True) + EPS)
    return (y * g.astype(jnp.float32)).astype(x.dtype)


def swiglu(x, w1, w3, w2):
    return (jax.nn.silu(x @ w1) * (x @ w3)) @ w2


def rope_tables(positions):
    inv_freq = ROPE_BASE ** (-jnp.arange(0, QK_ROPE_DIM, 2, dtype=jnp.float32) / QK_ROPE_DIM)
    ang = positions.astype(jnp.float32)[..., None] * inv_freq
    return jnp.cos(ang)[:, :, None, :], jnp.sin(ang)[:, :, None, :]


def apply_rope(x, cos, sin):
    x1, x2 = jnp.split(x.astype(jnp.float32), 2, axis=-1)
    out = jnp.concatenate([x1 * cos - x2 * sin, x2 * cos + x1 * sin], axis=-1)
    return out.astype(x.dtype)


def causal_block_attention(q, k, v):
    b, s, h, dqk = q.shape
    nb = s // Q_BLOCK
    scale = dqk ** -0.5
    qb = q.reshape(b, nb, Q_BLOCK, h, dqk).transpose(1, 0, 2, 3, 4)
    key_pos = jnp.arange(s)
    neg = jnp.finfo(jnp.float32).min

    def one_block(args):
        q_blk, blk = args
        q_pos = blk * Q_BLOCK + jnp.arange(Q_BLOCK)
        scores = jnp.einsum('bqhd,bkhd->bhqk', q_blk, k,
                            preferred_element_type=jnp.float32) * scale
        mask = key_pos[None, :] <= q_pos[:, None]
        scores = jnp.where(mask[None, None], scores, neg)
        probs = jax.nn.softmax(scores, axis=-1).astype(v.dtype)
        return jnp.einsum('bhqk,bkhd->bqhd', probs, v)

    out = lax.map(one_block, (qb, jnp.arange(nb)))
    return out.transpose(1, 0, 2, 3, 4).reshape(b, s, h, v.shape[-1])


def mla_mixer(c_q, c_kv, k_rope_raw, cos, sin, q_a_norm, w_uq, kv_a_norm, w_ukv, q_norm, k_norm):
    b, s, _ = c_q.shape
    q = (rms_norm(c_q, q_a_norm) @ w_uq).reshape(b, s, MLA_HEADS, QK_HEAD_DIM)
    kv = (rms_norm(c_kv, kv_a_norm) @ w_ukv).reshape(b, s, MLA_HEADS, QK_NOPE_DIM + V_HEAD_DIM)
    k_nope, v = jnp.split(kv, [QK_NOPE_DIM], axis=-1)
    k_rope = jnp.broadcast_to(k_rope_raw[:, :, None, :], (b, s, MLA_HEADS, QK_ROPE_DIM))
    k = jnp.concatenate([k_nope, k_rope], axis=-1)
    q = rms_norm(q, q_norm)
    k = rms_norm(k, k_norm)
    q = jnp.concatenate([q[..., :QK_NOPE_DIM], apply_rope(q[..., QK_NOPE_DIM:], cos, sin)], axis=-1)
    k = jnp.concatenate([k[..., :QK_NOPE_DIM], apply_rope(k[..., QK_NOPE_DIM:], cos, sin)], axis=-1)
    return causal_block_attention(q, k, v).reshape(b, s, ATTN_WIDTH)


def gmlp_mixer(u, v, v_norm, w_s, b_s):
    b, s, _ = u.shape
    u = jax.nn.gelu(u)
    v = rms_norm(jax.nn.gelu(v), v_norm)
    vc = v.reshape(b, s // CHUNK, CHUNK, GM_GROUPS, GM_GROUP_DIM)
    tril = jnp.tril(jnp.ones((CHUNK, CHUNK), dtype=bool))
    w_causal = jnp.where(tril[None], w_s, jnp.zeros_like(w_s))
    gate = jnp.einsum('gts,bcsgd->bctgd', w_causal, vc) + b_s.T[None, None, :, :, None]
    return u * gate.reshape(b, s, GM_WIDTH)


def setup_inputs(seed: int = 0) -> dict:
    key = jax.random.key(seed)
    ks = jax.random.split(key, 32)
    f32 = jnp.float32

    def w(k, shape, fan_in):
        return jax.random.normal(k, shape, f32) * fan_in ** -0.5

    def g(k, shape):
        return 1.0 + 0.05 * jax.random.normal(k, shape, f32)

    L = DEPTH
    offsets = jax.random.randint(ks[2], (BATCH, 1), 0, 1024, dtype=jnp.int32)
    positions = (offsets + jnp.arange(SEQ, dtype=jnp.int32)[None, :]).astype(jnp.int32)
    return {
        "x": jax.random.normal(ks[0], (BATCH, SEQ, D_MODEL), f32),
        "p": jax.random.normal(ks[1], (DEPTH, BATCH, SEQ, PLE_DIM), f32),
        "positions": positions,
        "ffn_a_norm": g(ks[3], (L, D_MODEL)),
        "ffn_a_w1": w(ks[4], (L, D_MODEL, D_FF), D_MODEL),
        "ffn_a_w3": w(ks[5], (L, D_MODEL, D_FF), D_MODEL),
        "ffn_a_w2": w(ks[6], (L, D_FF, D_MODEL), D_FF),
        "mix_norm": g(ks[7], (L, D_MODEL)),
        "w_in": w(ks[8], (L, D_MODEL, IN_COLS), D_MODEL),
        "q_a_norm": g(ks[9], (L, Q_LORA_RANK)),
        "w_uq": w(ks[10], (L, Q_LORA_RANK, MLA_HEADS * QK_HEAD_DIM), Q_LORA_RANK),
        "kv_a_norm": g(ks[11], (L, KV_LORA_RANK)),
        "w_ukv": w(ks[12], (L, KV_LORA_RANK, MLA_HEADS * (QK_NOPE_DIM + V_HEAD_DIM)), KV_LORA_RANK),
        "q_norm": g(ks[13], (L, QK_HEAD_DIM)),
        "k_norm": g(ks[14], (L, QK_HEAD_DIM)),
        "gm_v_norm": g(ks[15], (L, GM_WIDTH)),
        "gm_ws": w(ks[16], (L, GM_GROUPS, CHUNK, CHUNK), CHUNK),
        "gm_bs": 1.0 + 0.1 * jax.random.normal(ks[17], (L, GM_GROUPS, CHUNK), f32),
        "attn_out_norm": g(ks[18], (L, ATTN_WIDTH)),
        "gm_out_norm": g(ks[19], (L, GM_WIDTH)),
        "w_out": w(ks[20], (L, MIX_WIDTH, D_MODEL), MIX_WIDTH),
        "ffn_b_norm": g(ks[21], (L, D_MODEL)),
        "ffn_b_w1": w(ks[22], (L, D_MODEL, D_FF), D_MODEL),
        "ffn_b_w3": w(ks[23], (L, D_MODEL, D_FF), D_MODEL),
        "ffn_b_w2": w(ks[24], (L, D_FF, D_MODEL), D_FF),
        "ple_gate_norm": g(ks[25], (L, D_MODEL)),
        "w_ple_gate": w(ks[26], (L, D_MODEL, D_MODEL), D_MODEL),
        "w_ple": w(ks[27], (L, PLE_DIM, D_MODEL), PLE_DIM),
        "ple_norm": g(ks[28], (L, D_MODEL)),
    }


def reference(x, p, positions, ffn_a_norm, ffn_a_w1, ffn_a_w3, ffn_a_w2, mix_norm, w_in,
              q_a_norm, w_uq, kv_a_norm, w_ukv, q_norm, k_norm, gm_v_norm, gm_ws, gm_bs,
              attn_out_norm, gm_out_norm, w_out, ffn_b_norm, ffn_b_w1, ffn_b_w3, ffn_b_w2,
              ple_gate_norm, w_ple_gate, w_ple, ple_norm):
    cos, sin = rope_tables(positions)
    h = x
    for i in range(DEPTH):
        h = h + 0.5 * swiglu(rms_norm(h, ffn_a_norm[i]), ffn_a_w1[i], ffn_a_w3[i], ffn_a_w2[i])
        z = rms_norm(h, mix_norm[i]) @ w_in[i]
        c_q, c_kv, k_rope_raw, u, v = jnp.split(z, SPLITS, axis=-1)
        a_out = mla_mixer(c_q, c_kv, k_rope_raw, cos, sin, q_a_norm[i], w_uq[i],
                          kv_a_norm[i], w_ukv[i], q_norm[i], k_norm[i])
        g_out = gmlp_mixer(u, v, gm_v_norm[i], gm_ws[i], gm_bs[i])
        mixed = jnp.concatenate([rms_norm(a_out, attn_out_norm[i]),
                                 rms_norm(g_out, gm_out_norm[i])], axis=-1)
        h = h + mixed @ w_out[i]
        h = h + 0.5 * swiglu(rms_norm(h, ffn_b_norm[i]), ffn_b_w1[i], ffn_b_w3[i], ffn_b_w2[i])
        e = rms_norm(p[i] @ w_ple[i], ple_norm[i])
        gate = jax.nn.sigmoid(rms_norm(h, ple_gate_norm[i]) @ w_ple_gate[i])
        h = h + gate * e
    return h
```

```cpp
#include <hip/hip_runtime.h>
#include <hip/hip_cooperative_groups.h>
#include <cstdio>
#include <cstdint>
namespace cg = cooperative_groups;
namespace pg8 {
#define PG8_LAS __attribute__((address_space(3)))
typedef unsigned short bf16_t;
typedef short bf16x8 __attribute__((ext_vector_type(8)));
typedef float f32x4 __attribute__((ext_vector_type(4)));
typedef unsigned u32x4 __attribute__((ext_vector_type(4)));
constexpr int BM = 256, BK = 64, HALF = 128, HTB = HALF * BK * 2  , STAGE_BYTES = 8 * HTB, NXCD = 8, WGM = 8;

__host__ __device__ __forceinline__ int lds_byte(int r, int c) { const int st = (r >> 4) * 2 + (c >> 5), rr = r & 15, cc = c & 31, ob = rr * 64 + cc * 2; return st * 1024 + (ob ^ (((ob >> 9) & 1) << 5)); }
__host__ __device__ __forceinline__ void stage_rc(int b, int& R, int& C) { const int st = b / 1024, sb = b % 1024, swz = sb ^ (((sb >> 9) & 1) << 5); R = (st >> 1) * 16 + swz / 64; C = (st & 1) * 32 + (swz % 64) / 2; }
__host__ __device__ __forceinline__ int perm32(int rho) { const int n = rho >> 4, i = rho & 15; return 8 * (i >> 2) + 4 * n + (i & 3); }

struct Unit { int pm, pn; };
struct Gemm { const bf16_t* A; const bf16_t* Bt; int M, N, K, lda; };

struct StaticOrder {
    int nM, nN, nwg, G, c;
    __host__ __device__ void init(int M, int N, int G_, int c_) { nM = M / BM; nN = N / BM; nwg = nM * nN; G = G_; c = c_; }
    __host__ __device__ bool next(int i, Unit& u) const {
        const long L = (long)i * G + c; if (L >= nwg) return false;
        int wgid = (int)L; { const int q = nwg / NXCD, r = nwg % NXCD, xcd = wgid % NXCD, off = wgid / NXCD; wgid = (xcd < r ? xcd * (q + 1) : r * (q + 1) + (xcd - r) * q) + off; }
        const int nig = WGM * nN, gid = wgid / nig, fm = gid * WGM, gsz = (nM - fm) < WGM ? (nM - fm) : WGM;
        u.pm = fm + ((wgid % nig) % gsz); u.pn = (wgid % nig) / gsz; return true;
    }
    __device__ __forceinline__ void a_ready(const Unit&) const {}
    __device__ __forceinline__ void done(const Unit&) const {}
};

typedef float f32x2 __attribute__((ext_vector_type(2)));
typedef __bf16 bf16v2 __attribute__((ext_vector_type(2)));
typedef unsigned u32x2 __attribute__((ext_vector_type(2)));
__device__ __forceinline__ unsigned pk2(float lo, float hi) { f32x2 v = {lo, hi}; return __builtin_bit_cast(unsigned, __builtin_convertvector(v, bf16v2)); }
__device__ __forceinline__ float fast_sigmoid(float x) { return __builtin_amdgcn_rcpf(1.f + __builtin_amdgcn_exp2f(-1.4426950408889634f * x)); }

typedef unsigned long long ssq_t;
constexpr float SSQ_SCALE = 1048576.f, SSQ_INV = 1.f / 1048576.f;
__device__ __forceinline__ float ssq_to_f(ssq_t v) { return ((float)(unsigned)(v >> 32) * 4294967296.f + (float)(unsigned)v) * SSQ_INV; }
__device__ __forceinline__ ssq_t ssq_from_f(float s) { return (ssq_t)(s * SSQ_SCALE); }
__device__ __forceinline__ void row_ss_add(ssq_t* SS, int row, float ss, int fq) { ss += __shfl_xor(ss, 16); ss += __shfl_xor(ss, 32); if (fq == 0) __hip_atomic_fetch_add(SS + row, ssq_from_f(ss), __ATOMIC_RELAXED, __HIP_MEMORY_SCOPE_AGENT); }

template <bool RS, bool ACC> struct EpiBf16 {
    static constexpr bool PERM = true, AFTER_DRAIN = false;
    bf16_t* O; int ldc; const PG8_LAS float* RL; ssq_t* SSout;
    __device__ __forceinline__ void operator()(const f32x4 (&acc)[2][2][4][2], const Unit& u, int wr, int wc, int fr, int fq) const {
        const int row0 = u.pm * BM + wr * 64 + fr, col0 = u.pn * BM + wc * 32 + 8 * fq;
#pragma unroll
        for (int ai = 0; ai < 2; ++ai)
#pragma unroll
            for (int m = 0; m < 4; ++m) { const int row = row0 + ai * HALF + m * 16; bf16_t* rowp = O + (size_t)row * ldc + col0;
                const float r = RS ? RL[row & 4095] : 1.f; float ss = 0.f;
#pragma unroll
                for (int bj = 0; bj < 2; ++bj) { const f32x4 v0 = acc[ai][bj][m][0] * r, v1 = acc[ai][bj][m][1] * r;
                    if (ACC) ss += (v0[0] * v0[0] + v0[1] * v0[1]) + (v0[2] * v0[2] + v0[3] * v0[3]) + (v1[0] * v1[0] + v1[1] * v1[1]) + (v1[2] * v1[2] + v1[3] * v1[3]);
                    u32x4 w; w.x = pk2(v0[0], v0[1]); w.y = pk2(v0[2], v0[3]); w.z = pk2(v1[0], v1[1]); w.w = pk2(v1[2], v1[3]);
                    *(u32x4*)(rowp + bj * HALF) = w; }
                if (ACC) row_ss_add(SSout, row, ss, fq); }
    }
};
struct EpiZ {
    static constexpr bool PERM = true, AFTER_DRAIN = false;
    bf16_t* O; int ldc; const PG8_LAS float* RL; ssq_t* SSq; ssq_t* SSkv;
    __device__ __forceinline__ void operator()(const f32x4 (&acc)[2][2][4][2], const Unit& u, int wr, int wc, int fr, int fq) const {
        const int row0 = u.pm * BM + wr * 64 + fr, col0 = u.pn * BM + wc * 32 + 8 * fq;
        ssq_t* acc_to = u.pn < 2 ? SSq : SSkv; const bool do_acc = u.pn < 3;
#pragma unroll
        for (int ai = 0; ai < 2; ++ai)
#pragma unroll
            for (int m = 0; m < 4; ++m) { const int row = row0 + ai * HALF + m * 16; bf16_t* rowp = O + (size_t)row * ldc + col0;
                const float r = RL[row & 4095]; float ss = 0.f;
#pragma unroll
                for (int bj = 0; bj < 2; ++bj) { const f32x4 v0 = acc[ai][bj][m][0] * r, v1 = acc[ai][bj][m][1] * r;
                    ss += (v0[0] * v0[0] + v0[1] * v0[1]) + (v0[2] * v0[2] + v0[3] * v0[3]) + (v1[0] * v1[0] + v1[1] * v1[1]) + (v1[2] * v1[2] + v1[3] * v1[3]);
                    u32x4 w; w.x = pk2(v0[0], v0[1]); w.y = pk2(v0[2], v0[3]); w.z = pk2(v1[0], v1[1]); w.w = pk2(v1[2], v1[3]);
                    *(u32x4*)(rowp + bj * HALF) = w; }
                if (do_acc) row_ss_add(acc_to, row, ss, fq); }
    }
};
struct EpiSwiglu {
    static constexpr bool PERM = true, AFTER_DRAIN = false;
    bf16_t* O; int ldc; const PG8_LAS float* RL;
    __device__ __forceinline__ void operator()(const f32x4 (&acc)[2][2][4][2], const Unit& u, int wr, int wc, int fr, int fq) const {
        const int row0 = u.pm * BM + wr * 64 + fr, col0 = u.pn * HALF + wc * 32 + 8 * fq;
#pragma unroll
        for (int ai = 0; ai < 2; ++ai)
#pragma unroll
            for (int m = 0; m < 4; ++m) { const int row = row0 + ai * HALF + m * 16; bf16_t* rowp = O + (size_t)row * ldc + col0;
                const float rs = RL[row & 4095];
                float r[8];
#pragma unroll
                for (int n = 0; n < 2; ++n)
#pragma unroll
                    for (int j = 0; j < 4; ++j) { const float a = acc[ai][0][m][n][j] * rs, b = acc[ai][1][m][n][j] * rs; r[n * 4 + j] = a * fast_sigmoid(a) * b; }
                u32x4 w; w.x = pk2(r[0], r[1]); w.y = pk2(r[2], r[3]); w.z = pk2(r[4], r[5]); w.w = pk2(r[6], r[7]);
                *(u32x4*)rowp = w; }
    }
};
__device__ __forceinline__ f32x4 unpack4(u32x2 v) { return (f32x4){__uint_as_float(v.x << 16), __uint_as_float(v.x & 0xffff0000u), __uint_as_float(v.y << 16), __uint_as_float(v.y & 0xffff0000u)}; }
struct EpiResid {
    static constexpr bool PERM = true, AFTER_DRAIN = false;
    const bf16_t* Rin; bf16_t* HB; ssq_t* SSout; int ldc; float scale;
    __device__ __forceinline__ void operator()(const f32x4 (&acc)[2][2][4][2], const Unit& u, int wr, int wc, int fr, int fq) const {
        const int row0 = u.pm * BM + wr * 64 + fr, col0 = u.pn * BM + wc * 32 + 8 * fq;
        u32x4 h[2][4][2];
#pragma unroll
        for (int ai = 0; ai < 2; ++ai)
#pragma unroll
            for (int m = 0; m < 4; ++m) { const size_t off = (size_t)(row0 + ai * HALF + m * 16) * ldc + col0;
#pragma unroll
                for (int bj = 0; bj < 2; ++bj) h[ai][m][bj] = *(const u32x4*)(Rin + off + bj * HALF); }
        asm volatile("" ::: "memory");
#pragma unroll
        for (int ai = 0; ai < 2; ++ai)
#pragma unroll
            for (int m = 0; m < 4; ++m) { const int row = row0 + ai * HALF + m * 16; const size_t off = (size_t)row * ldc + col0; float ss = 0.f;
#pragma unroll
                for (int bj = 0; bj < 2; ++bj) { const u32x4 hv = h[ai][m][bj];
                    const f32x4 o0 = unpack4((u32x2){hv.x, hv.y}) + acc[ai][bj][m][0] * scale, o1 = unpack4((u32x2){hv.z, hv.w}) + acc[ai][bj][m][1] * scale;
                    ss += (o0[0] * o0[0] + o0[1] * o0[1]) + (o0[2] * o0[2] + o0[3] * o0[3]) + (o1[0] * o1[0] + o1[1] * o1[1]) + (o1[2] * o1[2] + o1[3] * o1[3]);
                    u32x4 w; w.x = pk2(o0[0], o0[1]); w.y = pk2(o0[2], o0[3]); w.z = pk2(o1[0], o1[1]); w.w = pk2(o1[2], o1[3]); *(u32x4*)(HB + off + bj * HALF) = w; }
                row_ss_add(SSout, row, ss, fq); }
    }
};
template <bool LAST> struct EpiGate {
    static constexpr bool PERM = true, AFTER_DRAIN = false;
    const bf16_t* Rin; float* Hout; const bf16_t* E; const ssq_t* SSin; const ssq_t* SSE; const float* pn; bf16_t* HB; ssq_t* SSout; int ldc;
    __device__ __forceinline__ void operator()(const f32x4 (&acc)[2][2][4][2], const Unit& u, int wr, int wc, int fr, int fq) const {
        const int row0 = u.pm * BM + wr * 64 + fr, col0 = u.pn * BM + wc * 32 + 8 * fq;
        f32x4 g[2][2];
#pragma unroll
        for (int bj = 0; bj < 2; ++bj)
#pragma unroll
            for (int n = 0; n < 2; ++n) g[bj][n] = *(const f32x4*)(pn + col0 + bj * HALF + n * 4);
#pragma unroll
        for (int ai = 0; ai < 2; ++ai)
#pragma unroll
            for (int mp = 0; mp < 2; ++mp) {
                u32x4 h[2][2], ev[2][2]; ssq_t rh[2], re[2];
#pragma unroll
                for (int mm = 0; mm < 2; ++mm) { const int row = row0 + ai * HALF + (mp * 2 + mm) * 16; const size_t off = (size_t)row * ldc + col0; rh[mm] = SSin[row]; re[mm] = SSE[row];
#pragma unroll
                    for (int bj = 0; bj < 2; ++bj) { h[mm][bj] = *(const u32x4*)(Rin + off + bj * HALF); ev[mm][bj] = *(const u32x4*)(E + off + bj * HALF); } }
                asm volatile("" ::: "memory");
#pragma unroll
                for (int mm = 0; mm < 2; ++mm) { const int m = mp * 2 + mm, row = row0 + ai * HALF + m * 16; const size_t off = (size_t)row * ldc + col0; float ss = 0.f;
                    const float rhv = rsqrtf(ssq_to_f(rh[mm]) * (1.f / 2048.f) + 1e-6f), rev = rsqrtf(ssq_to_f(re[mm]) * (1.f / 2048.f) + 1e-6f);
#pragma unroll
                    for (int bj = 0; bj < 2; ++bj) { f32x4 o[2];
#pragma unroll
                        for (int n = 0; n < 2; ++n) { const f32x4 hv = unpack4(n ? (u32x2){h[mm][bj].z, h[mm][bj].w} : (u32x2){h[mm][bj].x, h[mm][bj].y}), e = unpack4(n ? (u32x2){ev[mm][bj].z, ev[mm][bj].w} : (u32x2){ev[mm][bj].x, ev[mm][bj].y});
                            const f32x4 a = acc[ai][bj][m][n] * rhv; const f32x4 gg = g[bj][n] * rev;
                            o[n][0] = hv[0] + fast_sigmoid(a[0]) * (e[0] * gg[0]); o[n][1] = hv[1] + fast_sigmoid(a[1]) * (e[1] * gg[1]);
                            o[n][2] = hv[2] + fast_sigmoid(a[2]) * (e[2] * gg[2]); o[n][3] = hv[3] + fast_sigmoid(a[3]) * (e[3] * gg[3]); }
                        if (LAST) { __builtin_nontemporal_store(o[0], (f32x4*)(Hout + off + bj * HALF)); __builtin_nontemporal_store(o[1], (f32x4*)(Hout + off + bj * HALF + 4)); }
                        else { ss += (o[0][0] * o[0][0] + o[0][1] * o[0][1]) + (o[0][2] * o[0][2] + o[0][3] * o[0][3]) + (o[1][0] * o[1][0] + o[1][1] * o[1][1]) + (o[1][2] * o[1][2] + o[1][3] * o[1][3]);
                            u32x4 w; w.x = pk2(o[0][0], o[0][1]); w.y = pk2(o[0][2], o[0][3]); w.z = pk2(o[1][0], o[1][1]); w.w = pk2(o[1][2], o[1][3]); *(u32x4*)(HB + off + bj * HALF) = w; } }
                    if (!LAST) row_ss_add(SSout, row, ss, fq); }
                asm volatile("" ::: "memory");
            }
    }
};

template <class Epi, class Sched, bool ALIGN_EPI = false, bool SP2 = false>
__device__ __forceinline__ void gemm_phase(PG8_LAS unsigned char* lds, const Gemm g, const Sched& S, const Epi& E, const int tid_in) {
    const int tid = tid_in, wid = __builtin_amdgcn_readfirstlane(tid >> 6), lane = tid & 63, wr = wid >> 2, wc = wid & 3, fr = lane & 15, fq = lane >> 4;
    const int K = g.K, nt = K / BK;
    unsigned voffA[2], voffB[2];
#pragma unroll
    for (int i = 0; i < 2; ++i) { int R, C; stage_rc(tid * 16 + i * 8192, R, C); const int Rb = Epi::PERM ? ((R & ~31) + perm32(R & 31)) : R;
        voffA[i] = (unsigned)(R * g.lda + C) * 2u; voffB[i] = (unsigned)(Rb * K + C) * 2u; }
    const size_t kstep = (size_t)(BK * 2);
    const size_t hstep = (size_t)HALF * K * 2;
    const size_t tstep = 2 * hstep;
    const size_t hstepA = (size_t)HALF * g.lda * 2, tstepA = 2 * hstepA;
    const unsigned ldsw = (unsigned)wid * 1024u;
    const int aoff = lds_byte(wr * 64 + fr, fq * 8), boff = lds_byte(wc * 32 + fr, fq * 8);
#define PG8_SA(b, h) (((b) * 2 + (h)) * HTB)
#define PG8_SB(b, h) ((4 + (b) * 2 + (h)) * HTB)
#define PG8_STAGE(bufoff, gbase, voff) do { _Pragma("unroll") for (int _i = 0; _i < 2; ++_i) \
        __builtin_amdgcn_global_load_lds((const unsigned*)((const char*)(gbase) + (voff)[_i]), (PG8_LAS unsigned*)(lds + (bufoff) + ldsw + _i * 8192), 16, 0, 0); } while (0)
#define PG8_LDA(dst, b, h) do { _Pragma("unroll") for (int m = 0; m < 4; ++m) _Pragma("unroll") for (int k = 0; k < 2; ++k) dst[m][k] = *(const PG8_LAS bf16x8*)(lds + PG8_SA(b, h) + aoff + m * 2048 + k * 1024); } while (0)
#define PG8_LDB(dst, b, h) do { _Pragma("unroll") for (int n = 0; n < 2; ++n) _Pragma("unroll") for (int k = 0; k < 2; ++k) dst[n][k] = *(const PG8_LAS bf16x8*)(lds + PG8_SB(b, h) + boff + n * 2048 + k * 1024); } while (0)
#define PG8_MMA(ai, bj, At, Bt) do { __builtin_amdgcn_s_setprio(1); _Pragma("unroll") for (int m = 0; m < 4; ++m) _Pragma("unroll") for (int n = 0; n < 2; ++n) _Pragma("unroll") for (int k = 0; k < 2; ++k) \
        acc[ai][bj][m][n] = __builtin_amdgcn_mfma_f32_16x16x32_bf16(Bt[n][k], At[m][k], acc[ai][bj][m][n], 0, 0, 0); __builtin_amdgcn_s_setprio(0); } while (0)
#define PG8_WAIT_V(n) asm volatile("s_waitcnt vmcnt(" #n ")" ::: "memory")
#define PG8_WAIT_L(n) asm volatile("s_waitcnt lgkmcnt(" #n ")" ::: "memory")
#define PG8_BAR __builtin_amdgcn_s_barrier()
#define PG8_SCHED __builtin_amdgcn_sched_barrier(0)
    Unit cur, nxt; int ui = 0;
    if (!S.next(0, cur)) return;
    f32x4 acc[2][2][4][2];
#pragma unroll
    for (int a = 0; a < 2; ++a)
#pragma unroll
        for (int b = 0; b < 2; ++b)
#pragma unroll
            for (int m = 0; m < 4; ++m)
#pragma unroll
                for (int n = 0; n < 2; ++n) acc[a][b][m][n] = (f32x4){0.f, 0.f, 0.f, 0.f};
    bf16x8 At[4][2], B0[2][2], B1[2][2];
    const char* cA = (const char*)g.A + (size_t)cur.pm * tstepA; const char* cB = (const char*)g.Bt + (size_t)cur.pn * tstep;
    S.a_ready(cur);
    if constexpr (SP2) {
        PG8_STAGE(PG8_SB(0, 0), cB, voffB); PG8_STAGE(PG8_SB(0, 1), cB + hstep, voffB); PG8_STAGE(PG8_SA(0, 0), cA, voffA); PG8_STAGE(PG8_SA(0, 1), cA + hstepA, voffA);
        if (wr == 1) PG8_BAR;
        PG8_WAIT_V(2); PG8_BAR;
        PG8_STAGE(PG8_SB(1, 0), cB + kstep, voffB); PG8_STAGE(PG8_SA(1, 0), cA + kstep, voffA); PG8_STAGE(PG8_SB(1, 1), cB + hstep + kstep, voffB);
        PG8_WAIT_V(6); PG8_BAR;
    } else {
        PG8_STAGE(PG8_SB(0, 0), cB, voffB); PG8_STAGE(PG8_SA(0, 0), cA, voffA); PG8_STAGE(PG8_SB(0, 1), cB + hstep, voffB); PG8_STAGE(PG8_SA(0, 1), cA + hstepA, voffA);
        if (wr == 1) PG8_BAR;
        PG8_WAIT_V(4); PG8_BAR;
        PG8_STAGE(PG8_SB(1, 0), cB + kstep, voffB); PG8_STAGE(PG8_SA(1, 0), cA + kstep, voffA); PG8_STAGE(PG8_SB(1, 1), cB + hstep + kstep, voffB);
        PG8_WAIT_V(6); PG8_BAR;
    }
    for (;;) {
        const bool has_next = S.next(ui + 1, nxt);
        const char* nA = has_next ? (const char*)g.A + (size_t)nxt.pm * tstepA : cA; const char* nB = has_next ? (const char*)g.Bt + (size_t)nxt.pn * tstep : cB;
        for (int t = 0; t < nt; t += 2) {
            const bool last = (t == nt - 2);
            const char* a1 = cA + (size_t)(t + 1) * kstep;
            const char* a2 = last ? nA : cA + (size_t)(t + 2) * kstep; const char* b2 = last ? nB : cB + (size_t)(t + 2) * kstep;
            const char* a3 = a2 + kstep; const char* b3 = b2 + kstep;
            if (last && has_next) S.a_ready(nxt);
            if constexpr (SP2) {
            PG8_LDB(B0, 0, 0); PG8_LDB(B1, 0, 1); PG8_SCHED; PG8_LDA(At, 0, 0); PG8_STAGE(PG8_SA(1, 1), a1 + hstepA, voffA);
            PG8_WAIT_V(8); PG8_WAIT_L(0); PG8_BAR; PG8_MMA(0, 0, At, B0); PG8_MMA(0, 1, At, B1); PG8_BAR; PG8_SCHED;
            PG8_LDA(At, 0, 1); PG8_STAGE(PG8_SB(0, 0), b2, voffB); PG8_STAGE(PG8_SB(0, 1), b2 + hstep, voffB); PG8_STAGE(PG8_SA(0, 0), a2, voffA);
            PG8_WAIT_V(8); PG8_WAIT_L(0); PG8_BAR; PG8_MMA(1, 0, At, B0); PG8_MMA(1, 1, At, B1); PG8_BAR; PG8_SCHED;
            PG8_LDB(B0, 1, 0); PG8_LDB(B1, 1, 1); PG8_SCHED; PG8_LDA(At, 1, 0); PG8_STAGE(PG8_SA(0, 1), a2 + hstepA, voffA);
            PG8_WAIT_V(8); PG8_WAIT_L(0); PG8_BAR; PG8_MMA(0, 0, At, B0); PG8_MMA(0, 1, At, B1); PG8_BAR; PG8_SCHED;
            PG8_LDA(At, 1, 1); PG8_STAGE(PG8_SB(1, 0), b3, voffB); PG8_STAGE(PG8_SB(1, 1), b3 + hstep, voffB); PG8_STAGE(PG8_SA(1, 0), a3, voffA);
            PG8_WAIT_V(8); PG8_WAIT_L(0); PG8_BAR; PG8_MMA(1, 0, At, B0); PG8_MMA(1, 1, At, B1); PG8_BAR; PG8_SCHED;
            } else {
            PG8_LDB(B0, 0, 0); PG8_SCHED; PG8_LDA(At, 0, 0); PG8_STAGE(PG8_SA(1, 1), a1 + hstepA, voffA);
            PG8_WAIT_L(8); PG8_BAR; PG8_WAIT_L(0); PG8_MMA(0, 0, At, B0); PG8_BAR; PG8_SCHED;
            PG8_LDB(B1, 0, 1); PG8_STAGE(PG8_SB(0, 0), b2, voffB);
            PG8_BAR; PG8_WAIT_L(0); PG8_MMA(0, 1, At, B1); PG8_BAR;
            PG8_LDA(At, 0, 1); PG8_STAGE(PG8_SA(0, 0), a2, voffA);
            PG8_BAR; PG8_WAIT_L(0); PG8_MMA(1, 0, At, B0); PG8_BAR; PG8_SCHED;
            PG8_STAGE(PG8_SB(0, 1), b2 + hstep, voffB);
            PG8_WAIT_V(6); PG8_BAR; PG8_MMA(1, 1, At, B1); PG8_BAR;
            PG8_LDB(B0, 1, 0); PG8_SCHED; PG8_LDA(At, 1, 0); PG8_STAGE(PG8_SA(0, 1), a2 + hstepA, voffA);
            PG8_WAIT_L(8); PG8_BAR; PG8_WAIT_L(0); PG8_MMA(0, 0, At, B0); PG8_BAR; PG8_SCHED;
            PG8_LDB(B1, 1, 1); PG8_STAGE(PG8_SB(1, 0), b3, voffB);
            PG8_BAR; PG8_WAIT_L(0); PG8_MMA(0, 1, At, B1); PG8_BAR;
            PG8_LDA(At, 1, 1); PG8_STAGE(PG8_SA(1, 0), a3, voffA);
            PG8_BAR; PG8_WAIT_L(0); PG8_MMA(1, 0, At, B0); PG8_BAR; PG8_SCHED;
            PG8_STAGE(PG8_SB(1, 1), b3 + hstep, voffB);
            PG8_WAIT_V(6); PG8_BAR; PG8_MMA(1, 1, At, B1); PG8_BAR;
            }
        }
        if constexpr (ALIGN_EPI) { if (wr == 0) PG8_BAR; }
        if constexpr (!Epi::AFTER_DRAIN) { E(acc, cur, wr, wc, fr, fq); S.done(cur); }
        if (!has_next) break;
#pragma unroll
        for (int a = 0; a < 2; ++a)
#pragma unroll
            for (int b = 0; b < 2; ++b)
#pragma unroll
                for (int m = 0; m < 4; ++m)
#pragma unroll
                    for (int n = 0; n < 2; ++n) acc[a][b][m][n] = (f32x4){0.f, 0.f, 0.f, 0.f};
        cur = nxt; cA = nA; cB = nB; ++ui;
        if constexpr (ALIGN_EPI) { if (wr == 1) PG8_BAR; }
    }
    PG8_WAIT_V(0);
    if constexpr (!ALIGN_EPI) { if (wr == 0) PG8_BAR; }
    PG8_BAR;
    if constexpr (Epi::AFTER_DRAIN) { E.fused(acc, cur, wr, wc, fr, fq, lds, wid, lane); S.done(cur); }
#undef PG8_SA
#undef PG8_SB
#undef PG8_STAGE
#undef PG8_LDA
#undef PG8_LDB
#undef PG8_MMA
#undef PG8_WAIT_V
#undef PG8_WAIT_L
#undef PG8_BAR
#undef PG8_SCHED
}
}

#define GAS __attribute__((address_space(1)))
#define LAS __attribute__((address_space(3)))
#define DI __device__ __forceinline__
#define LDS_WAIT() asm volatile("s_waitcnt lgkmcnt(0)" ::: "memory")
using pg8::ssq_t; using pg8::bf16_t; using pg8::bf16x8; using pg8::f32x4; using pg8::u32x4; using pg8::u32x2; using pg8::pk2;
typedef float f32x16 __attribute__((ext_vector_type(16)));

constexpr int T = 32768, DM = 2048, DFF = 5504, NINP = 3072, SEQ = 4096;
constexpr int NWAVES = 8, NTHREADS = 512, LDS_BYTES = 131072 + 16384, RL_OFF = 131072;
constexpr float EPS = 1e-6f;
constexpr int ZC_KV = 512, ZC_ROPE = 768, ZC_U = 832, ZC_V = 1856;
constexpr int GO_PITCH = 4096;

constexpr size_t O_W13A = 0, O_W13B = 45088768, O_W2A = 90177536, O_W2B = 112721920, O_WIN = 135266304, O_WUQ = 147849216, O_WUKV = 149422080, O_WOUT = 150470656, O_WGATE = 158859264, O_WPLE = 167247872;
constexpr size_t O_XN = 168296448, O_ER = O_XN + 134217728, O_PB = O_ER + 134217728, O_BIG = O_PB + 16777216;
constexpr size_t O_ACT = O_BIG, O_Z = O_BIG, O_QR = O_BIG + 201326592, O_KVR = O_QR + 100663296, O_KB = O_KVR + 134217728, O_VT = O_KB + 100663296, O_END = O_VT + 67108864;
constexpr size_t O_CQN = O_KB, O_CKVN = O_VT, O_AO = O_KVR, O_GO = O_KVR + 67108864;
constexpr size_t SLAB = 75497472, S_ACT = 0, S_Z = 0, S_MIX = 0, S_QR = 25165824, S_KVR = S_QR + 12582912, S_AO = S_KVR, S_GO = S_KVR + 8388608, S_KB = S_KVR + 16777216, S_VT = S_KB + 12582912, S_CQN = S_KB, S_CKVN = S_VT, S_HBALT = S_KB;
constexpr size_t BB_ACT = (size_t)SEQ * DFF * 2, BB_Z = (size_t)SEQ * NINP * 2, BB_MIX = (size_t)SEQ * DM * 2, BB_QR = (size_t)SEQ * 1536 * 2, BB_KVR = (size_t)SEQ * 2048 * 2, BB_AO = (size_t)SEQ * 1024 * 2, BB_KB = (size_t)8 * SEQ * 192 * 2, BB_VT = (size_t)8 * 128 * SEQ * 2, BB_CQN = (size_t)SEQ * 512 * 2, BB_CKVN = (size_t)SEQ * 256 * 2, BB_HB = (size_t)SEQ * DM * 2;
static_assert(S_VT + BB_VT == SLAB && S_HBALT + BB_HB <= SLAB && BB_ACT <= SLAB && 8 * SLAB == 603979776, "slab map");
constexpr size_t O_HB = O_XN  , O_HBALT = O_KB  , O_MIX = O_BIG  ;
constexpr size_t O_SS = O_END  , O_SSE = O_SS + 8 * 262144  , O_SSQ = O_SSE + 2 * 262144  , O_BAR = O_SSQ + 4 * 262144  , O_END2 = O_BAR + 4096;

struct Args { const float* in[29]; float* out; unsigned char* ws; };
typedef const __attribute__((address_space(4))) Args* ArgsP;
DI ArgsP args_ptr() { ArgsP p = (ArgsP)__builtin_amdgcn_kernarg_segment_ptr(); asm volatile("" : "+s"(p)); return p; }
DI int fresh_tid() { int t = threadIdx.x; asm volatile("" : "+v"(t)); return t; }
struct Grp { int grp, mi, GM, r0, rstride, rend; };
DI Grp make_grp(int G) { Grp g; g.grp = blockIdx.x & 7; g.mi = blockIdx.x >> 3; g.GM = G >> 3; g.r0 = g.grp * SEQ + g.mi * NWAVES; g.rstride = g.GM * NWAVES; g.rend = (g.grp + 1) * SEQ; return g; }

DI float wave_sum(float v) {
#pragma unroll
    for (int o = 1; o < 64; o <<= 1) v += __shfl_xor(v, o);
    return v;
}
DI float blo(unsigned u) { return __uint_as_float(u << 16); }
DI float bhi(unsigned u) { return __uint_as_float(u & 0xffff0000u); }
DI float gelu_tanh(float x) { const float u = x * (1.f + 0.044715f * x * x); return x * __builtin_amdgcn_rcpf(1.f + __builtin_amdgcn_exp2f(-2.3022081981f * u)); }
DI float dot4(f32x4 v) { return (v[0] * v[0] + v[1] * v[1]) + (v[2] * v[2] + v[3] * v[3]); }

struct CvtD { const float* src; const float* gain; bf16_t* dst; int N, K; };
DI CvtD cvt_mk(const float* W, int K, int N, bf16_t* WT, int mode, int item, const float* gain) {
    const int nblk = N >> 5, kb = item / nblk, nb = item - kb * nblk, k0 = kb * 64, n0 = nb * 32;
    int d0 = n0; if (mode) d0 = (n0 >> 7) * 256 + (n0 & 127) + (mode == 2 ? 128 : 0);
    CvtD d; d.src = W + (size_t)k0 * N + n0; d.gain = gain ? gain + k0 : nullptr; d.dst = WT + (size_t)d0 * K + k0; d.N = N; d.K = K; return d;
}
DI CvtD cvt_desc(ArgsP A, int layer, int it) {
    unsigned char* ws = A->ws;
    constexpr int I_FF = 32 * 172, I_2 = 86 * 64, I_IN = 32 * 90, I_UQ = 8 * 48, I_UKV = 4 * 64, I_SQ = 32 * 64;
    const size_t LFF = (size_t)layer * DM * DFF, LSQ = (size_t)layer * DM * DM;
    int r = it;
    if (r < I_FF) return cvt_mk(A->in[4] + LFF, DM, DFF, (bf16_t*)(ws + O_W13A), 1, r, A->in[3] + layer * DM); r -= I_FF;
    if (r < I_FF) return cvt_mk(A->in[5] + LFF, DM, DFF, (bf16_t*)(ws + O_W13A), 2, r, A->in[3] + layer * DM); r -= I_FF;
    if (r < I_2)  return cvt_mk(A->in[6] + LFF, DFF, DM, (bf16_t*)(ws + O_W2A), 0, r, nullptr); r -= I_2;
    if (r < I_FF) return cvt_mk(A->in[22] + LFF, DM, DFF, (bf16_t*)(ws + O_W13B), 1, r, A->in[21] + layer * DM); r -= I_FF;
    if (r < I_FF) return cvt_mk(A->in[23] + LFF, DM, DFF, (bf16_t*)(ws + O_W13B), 2, r, A->in[21] + layer * DM); r -= I_FF;
    if (r < I_2)  return cvt_mk(A->in[24] + LFF, DFF, DM, (bf16_t*)(ws + O_W2B), 0, r, nullptr); r -= I_2;
    if (r < I_IN) return cvt_mk(A->in[8] + (size_t)layer * DM * 2880, DM, 2880, (bf16_t*)(ws + O_WIN), 0, r, A->in[7] + layer * DM); r -= I_IN;
    if (r < I_UQ) return cvt_mk(A->in[10] + (size_t)layer * 512 * 1536, 512, 1536, (bf16_t*)(ws + O_WUQ), 0, r, A->in[9] + layer * 512); r -= I_UQ;
    if (r < I_UKV) return cvt_mk(A->in[12] + (size_t)layer * 256 * 2048, 256, 2048, (bf16_t*)(ws + O_WUKV), 0, r, A->in[11] + layer * 256); r -= I_UKV;
    if (r < I_SQ) return cvt_mk(A->in[20] + LSQ, DM, DM, (bf16_t*)(ws + O_WOUT), 0, r, nullptr); r -= I_SQ;
    if (r < I_SQ) return cvt_mk(A->in[26] + LSQ, DM, DM, (bf16_t*)(ws + O_WGATE), 0, r, A->in[25] + layer * DM); r -= I_SQ;
    return cvt_mk(A->in[27] + (size_t)layer * 256 * 2048, 256, 2048, (bf16_t*)(ws + O_WPLE), 0, r, nullptr);
}
DI void cvt_load(const CvtD& d, float (&v)[32], int lane) {
    const float* src = d.src + (size_t)(lane >> 5) * d.N + (lane & 31);
#pragma unroll
    for (int i = 0; i < 32; ++i) v[i] = __builtin_nontemporal_load(src + (size_t)(2 * i) * d.N);
}
DI void cvt_store(const CvtD& d, const float (&v)[32], LAS float* scr, int lane) {
#pragma unroll
    for (int i = 0; i < 32; ++i) scr[(2 * i + (lane >> 5)) * 33 + (lane & 31)] = v[i];
    LDS_WAIT();
    const int c = lane & 7;
    f32x4 g0 = {1.f, 1.f, 1.f, 1.f}, g1 = g0;
    if (d.gain) { g0 = *(const f32x4*)(d.gain + 8 * c); g1 = *(const f32x4*)(d.gain + 8 * c + 4); }
#pragma unroll
    for (int j = 0; j < 4; ++j) { const int n = (lane >> 3) + 8 * j; const LAS float* s = scr + (8 * c) * 33 + n;
        u32x4 o; o.x = pk2(s[0] * g0[0], s[33] * g0[1]); o.y = pk2(s[66] * g0[2], s[99] * g0[3]); o.z = pk2(s[132] * g1[0], s[165] * g1[1]); o.w = pk2(s[198] * g1[2], s[231] * g1[3]);
        *(u32x4*)(d.dst + (size_t)n * d.K + 8 * c) = o; }
    LDS_WAIT();
}
DI void phase_convert(ArgsP A, int layer, LAS unsigned char* lds, int tid, int wave, int lane, int G) {
    LAS float* scr = (LAS float*)(lds + wave * 8448);
    unsigned char* ws = A->ws;
    const int gw = blockIdx.x * NWAVES + wave, NGW = G * NWAVES;
    constexpr int NITEMS = 4 * (32 * 172) + 2 * (86 * 64) + 32 * 90 + 8 * 48 + 4 * 64 + 2 * (32 * 64) + 4 * 64;
    { CvtD nd; float nv[32];
      if (gw < NITEMS) { nd = cvt_desc(A, layer, gw); cvt_load(nd, nv, lane); }
      for (int it = gw; it < NITEMS; it += NGW) {
          const CvtD cd = nd; float cv[32];
#pragma unroll
          for (int i = 0; i < 32; ++i) cv[i] = nv[i];
          if (it + NGW < NITEMS) { nd = cvt_desc(A, layer, it + NGW); cvt_load(nd, nv, lane); }
          cvt_store(cd, cv, scr, lane);
      } }
    const int gt = blockIdx.x * NTHREADS + tid, NGT = G * NTHREADS;
    { u32x4* z = (u32x4*)(ws + O_WIN + (size_t)2880 * DM * 2); const u32x4 zero = {0u, 0u, 0u, 0u};
      for (int i = gt; i < 192 * DM / 8; i += NGT) z[i] = zero; }
    { const f32x4* p = (const f32x4*)(A->in[1] + (size_t)layer * T * 256); u32x4* o = (u32x4*)(ws + O_PB);
      for (int i = gt; i < T * 256 / 8; i += NGT) { const f32x4 a = __builtin_nontemporal_load(p + 2 * i), b = __builtin_nontemporal_load(p + 2 * i + 1); u32x4 w; w.x = pk2(a[0], a[1]); w.y = pk2(a[2], a[3]); w.z = pk2(b[0], b[1]); w.w = pk2(b[2], b[3]); o[i] = w; } }
}

DI void phase_x0(const float* x, bf16_t* HB, ssq_t* SS, int tid, int wave, int lane, const Grp gr) {
    const int gw = gr.r0 + wave, NGW = gr.rstride, REND = gr.rend;
    for (int i = gr.mi * NTHREADS + tid; i < 13 * SEQ; i += gr.GM * NTHREADS) SS[(size_t)(1 + (i >> 12)) * T + gr.grp * SEQ + (i & 4095)] = 0ull;
    for (int row0 = gw; row0 < REND; row0 += 2 * NGW) {
        f32x4 v[2][8];
#pragma unroll
        for (int r = 0; r < 2; ++r) { const int row = row0 + r * NGW; if (row < REND) { const f32x4* xr = (const f32x4*)(x + (size_t)row * DM) + lane;
#pragma unroll
            for (int j = 0; j < 8; ++j) v[r][j] = __builtin_nontemporal_load(xr + 64 * j); } }
#pragma unroll
        for (int r = 0; r < 2; ++r) { const int row = row0 + r * NGW; if (row < REND) { float s = 0.f;
#pragma unroll
            for (int j = 0; j < 8; ++j) s += dot4(v[r][j]);
            s = wave_sum(s); if (lane == 0) SS[row] = pg8::ssq_from_f(s);
            u32x2* o = (u32x2*)(HB + (size_t)row * DM) + lane;
#pragma unroll
            for (int j = 0; j < 8; ++j) { u32x2 w; w.x = pk2(v[r][j][0], v[r][j][1]); w.y = pk2(v[r][j][2], v[r][j][3]); o[64 * j] = w; } } }
    }
}
DI void phase_mixnorm(const bf16_t* AO, const bf16_t* GO, const float* ga, const float* gg, bf16_t* XN, int wave, int lane, const Grp gr) {
    const int gw = gr.r0 + wave, NGW = gr.rstride, REND = gr.rend;
    for (int row0 = gw; row0 < REND; row0 += 4 * NGW) {
        u32x4 v[4][2][2];
#pragma unroll
        for (int r = 0; r < 4; ++r) { const int row = row0 + r * NGW; if (row < REND) {
#pragma unroll
            for (int part = 0; part < 2; ++part) { const bf16_t* src = part ? GO + (size_t)row * GO_PITCH : AO + (size_t)row * 1024;
#pragma unroll
                for (int j = 0; j < 2; ++j) v[r][part][j] = *(const u32x4*)(src + (lane + 64 * j) * 8); } } }
#pragma unroll
        for (int r = 0; r < 4; ++r) { const int row = row0 + r * NGW; if (row < REND) {
#pragma unroll
            for (int part = 0; part < 2; ++part) { const float* gn = part ? gg : ga; float s = 0.f;
#pragma unroll
                for (int j = 0; j < 2; ++j)
#pragma unroll
                    for (int k = 0; k < 4; ++k) { const float a = blo(v[r][part][j][k]), b = bhi(v[r][part][j][k]); s += a * a + b * b; }
                const float rstd = rsqrtf(wave_sum(s) * (1.f / 1024.f) + EPS);
#pragma unroll
                for (int j = 0; j < 2; ++j) { const int c0 = (lane + 64 * j) * 8; const f32x4 g0 = *(const f32x4*)(gn + c0), g1 = *(const f32x4*)(gn + c0 + 4); const u32x4 x = v[r][part][j]; u32x4 w;
                    w.x = pk2(blo(x.x) * rstd * g0[0], bhi(x.x) * rstd * g0[1]); w.y = pk2(blo(x.y) * rstd * g0[2], bhi(x.y) * rstd * g0[3]);
                    w.z = pk2(blo(x.z) * rstd * g1[0], bhi(x.z) * rstd * g1[1]); w.w = pk2(blo(x.w) * rstd * g1[2], bhi(x.w) * rstd * g1[3]);
                    *(u32x4*)(XN + (size_t)row * DM + part * 1024 + c0) = w; } } } }
    }
}

DI void norm_rope_store(const LAS float* buf, const LAS float* cs, const float* gain, float scale, bf16_t* dst, size_t hstride, int lane) {
    const int hd8 = lane >> 3, sub = lane & 7;
    const LAS f32x4* p = (const LAS f32x4*)(buf + hd8 * 192 + sub * 24);
    float ss = 0.f;
#pragma unroll
    for (int i = 0; i < 6; ++i) ss += dot4(p[i]);
    ss += __shfl_xor(ss, 1); ss += __shfl_xor(ss, 2); ss += __shfl_xor(ss, 4);
    const float rstd_own = rsqrtf(ss * (1.f / 192.f) + EPS) * scale;
#pragma unroll
    for (int j = 0; j < 3; ++j) {
        const int e0 = (lane + 64 * j) * 8, hd = e0 / 192, d0 = e0 - hd * 192;
        const float rs = __shfl(rstd_own, hd * 8);
        const f32x4 x0 = *(const LAS f32x4*)(buf + e0), x1 = *(const LAS f32x4*)(buf + e0 + 4), g0 = *(const f32x4*)(gain + d0), g1 = *(const f32x4*)(gain + d0 + 4);
        f32x4 v0 = x0 * g0, v1 = x1 * g1;
        if (d0 >= 128) {
            const bool lo = d0 < 160; const int po = lo ? 32 : -32, ci = lo ? d0 - 128 : d0 - 160;
            const f32x4 y0 = *(const LAS f32x4*)(buf + e0 + po), y1 = *(const LAS f32x4*)(buf + e0 + po + 4), h0 = *(const f32x4*)(gain + d0 + po), h1 = *(const f32x4*)(gain + d0 + po + 4);
            const f32x4 c0 = *(const LAS f32x4*)(cs + ci), c1 = *(const LAS f32x4*)(cs + ci + 4), s0 = *(const LAS f32x4*)(cs + 32 + ci), s1 = *(const LAS f32x4*)(cs + 32 + ci + 4);
            const f32x4 p0 = y0 * h0, p1 = y1 * h1;
            if (lo) { v0 = v0 * c0 - p0 * s0; v1 = v1 * c1 - p1 * s1; } else { v0 = v0 * c0 + p0 * s0; v1 = v1 * c1 + p1 * s1; }
        }
        v0 = v0 * rs; v1 = v1 * rs;
        u32x4 w; w.x = pk2(v0[0], v0[1]); w.y = pk2(v0[2], v0[3]); w.z = pk2(v1[0], v1[1]); w.w = pk2(v1[2], v1[3]);
        *(u32x4*)(dst + (size_t)hd * hstride + d0) = w;
    }
}
DI void store8f(LAS float* d, u32x4 a) {
    *(LAS f32x4*)d = (f32x4){blo(a.x), bhi(a.x), blo(a.y), bhi(a.y)}; *(LAS f32x4*)(d + 4) = (f32x4){blo(a.z), bhi(a.z), blo(a.w), bhi(a.w)};
}
DI void phase_prep_b(bf16_t* QR, const bf16_t* KVR, const bf16_t* Z, const int* positions, const float* qn, const float* kn, bf16_t* KB, bf16_t* VT, LAS unsigned char* lds, int tid, int wave, int lane, const Grp gr, const bool do_q = true) {
    LAS float* buf = (LAS float*)(lds + wave * 12544); LAS float* bufk = buf + 1536; LAS float* cs = buf + 3072;
    const int gw = gr.r0 + wave, NGW = gr.rstride, REND = gr.rend;
    const float qscale = 0.07216878364870322f * 1.4426950408889634f;
    double invf = 1.0; { double base = 0.7498942093324558;
#pragma unroll
        for (int bit = 0; bit < 5; ++bit) { if ((lane >> bit) & 1) invf *= base; base *= base; } }
    const float invf32 = (float)invf;
    u32x4 nq[3], nk[3]; int npos = 0;
#define PB_LOAD(tk) do { const bf16_t* qrow_ = QR + (size_t)(tk) * 1536; npos = positions[tk]; \
        _Pragma("unroll") for (int j = 0; j < 3; ++j) { nq[j] = *(const u32x4*)(qrow_ + (lane + 64 * j) * 8); \
            const int c = lane + 64 * j, hd = c / 24, cc = c - hd * 24; \
            const bf16_t* src = cc < 16 ? KVR + (size_t)(tk) * 2048 + hd * 256 + cc * 8 : Z + (size_t)(tk) * NINP + ZC_ROPE + (cc - 16) * 8; nk[j] = *(const u32x4*)src; } } while (0)
    if (gw < REND) PB_LOAD(gw);
    for (int tok = gw; tok < REND; tok += NGW) {
        const int b = tok >> 12, s = tok & 4095;
        u32x4 cq[3], ck[3]; const int pos = npos;
#pragma unroll
        for (int j = 0; j < 3; ++j) { cq[j] = nq[j]; ck[j] = nk[j]; }
        if (tok + NGW < REND) PB_LOAD(tok + NGW);
        if (lane < 32) { const float ang = (float)pos * invf32; double rev = (double)ang * 0.15915494309189535; rev -= __builtin_rint(rev); const float f = (float)rev;
            cs[lane] = __builtin_amdgcn_cosf(f); cs[32 + lane] = __builtin_amdgcn_sinf(f); }
        bf16_t* qrow = QR + (size_t)tok * 1536;
#pragma unroll
        for (int j = 0; j < 3; ++j) { store8f(buf + (lane + 64 * j) * 8, cq[j]); store8f(bufk + (lane + 64 * j) * 8, ck[j]); }
        LDS_WAIT();
        if (do_q) norm_rope_store(buf, cs, qn, qscale, qrow, 192, lane);
        norm_rope_store(bufk, cs, kn, 1.f, KB + ((size_t)(b * 8) * SEQ + s) * 192, (size_t)SEQ * 192, lane);
        LDS_WAIT();
    }
#undef PB_LOAD
}

#define MFMA32(a, b, c) __builtin_amdgcn_mfma_f32_32x32x16_bf16((a), (b), (c), 0, 0, 0)
typedef short s16x4 __attribute__((ext_vector_type(4)));
DI bf16x8 trv_read(const LAS unsigned char* p) {
    const s16x4 lo = __builtin_amdgcn_ds_read_tr16_b64_v4i16((LAS s16x4*)p), hi = __builtin_amdgcn_ds_read_tr16_b64_v4i16((LAS s16x4*)(p + 8 * 320));
    return (bf16x8){lo[0], lo[1], lo[2], lo[3], hi[0], hi[1], hi[2], hi[3]};
}
#define TRV(p) trv_read((const LAS unsigned char*)(p))
constexpr int KROW_B = 400, VROW_B = 320, KT_B = 64 * KROW_B, VT_B = 64 * VROW_B, STG_B = KT_B + VT_B;
DI void attn_block(const bf16_t* Q, const bf16_t* Kb, const bf16_t* Vt, bf16_t* AO, LAS unsigned char* lds, int bh, int qb, int tid, int wave, int lane) {
    const int b = bh >> 3, h = bh & 7, l31 = lane & 31, hh = lane >> 5;
    const int q0 = qb * 256, qw = q0 + wave * 32, nkt = 4 * (qb + 1);
    const bf16_t* Kbase = Kb + (size_t)bh * SEQ * 192; const bf16_t* Vbase = Vt + (size_t)b * SEQ * 2048 + h * 256 + 128;
    bf16x8 qf[12];
    { const bf16_t* qp = Q + (size_t)(b * SEQ + qw + l31) * 1536 + h * 192 + 8 * hh;
#pragma unroll
      for (int s = 0; s < 12; ++s) qf[s] = *(const bf16x8*)(qp + 16 * s); }
    f32x16 o[4];
#pragma unroll
    for (int d = 0; d < 4; ++d)
#pragma unroll
        for (int i = 0; i < 16; ++i) o[d][i] = 0.f;
    float m = -1e30f, l = 0.f;
    const int kgo = (tid >> 3) * 192 + (tid & 7) * 8, klo = (tid >> 3) * KROW_B + (tid & 7) * 16;
    const int vgo = (tid >> 4) * 2048 + (tid & 15) * 8, vlo = KT_B + (tid >> 4) * VROW_B + (tid & 15) * 16;
    u32x4 kr[3], vr[2];
#define ATT_GLOAD(kt) do { _Pragma("unroll") for (int i = 0; i < 3; ++i) kr[i] = *(const u32x4*)(Kbase + (size_t)(kt) * 64 * 192 + kgo + 64 * i); \
        _Pragma("unroll") for (int i = 0; i < 2; ++i) vr[i] = *(const u32x4*)(Vbase + (size_t)(kt) * 64 * 2048 + vgo + 32 * i * 2048); } while (0)
#define ATT_LSTORE(st) do { _Pragma("unroll") for (int i = 0; i < 3; ++i) *(LAS u32x4*)(lds + (st) * STG_B + klo + 128 * i) = kr[i]; \
        _Pragma("unroll") for (int i = 0; i < 2; ++i) *(LAS u32x4*)(lds + (st) * STG_B + vlo + 32 * i * VROW_B) = vr[i]; } while (0)
    ATT_GLOAD(0); ATT_LSTORE(0);
    __syncthreads();
    const int koff = l31 * KROW_B + 16 * hh, voff = KT_B + (4 * hh + ((lane >> 2) & 3)) * VROW_B + (16 * ((lane >> 4) & 1) + 4 * (lane & 3)) * 2;
    for (int kt = 0; kt < nkt; ++kt) {
        const int st = kt & 1, k0 = kt * 64;
        const bool more = kt + 1 < nkt;
        if (more) ATT_GLOAD(kt + 1);
        if (k0 <= qw + 31) {
            const LAS unsigned char* sb = lds + st * STG_B;
            f32x16 sa[2];
#pragma unroll
            for (int kb = 0; kb < 2; ++kb)
#pragma unroll
                for (int i = 0; i < 16; ++i) sa[kb][i] = 0.f;
            {
                bf16x8 fr[2][4];
#pragma unroll
                for (int j = 0; j < 4; ++j) fr[0][j] = *(const LAS bf16x8*)(sb + koff + 32 * j);
                __builtin_amdgcn_sched_barrier(0);
#pragma unroll
                for (int g = 0; g < 6; ++g) {
                    if (g < 5) {
#pragma unroll
                        for (int j = 0; j < 4; ++j) { const int s = (g + 1) * 4 + j; fr[(g + 1) & 1][j] = *(const LAS bf16x8*)(sb + koff + (s / 12) * 32 * KROW_B + 32 * (s % 12)); }
                    }
#pragma unroll
                    for (int j = 0; j < 4; ++j) { const int s = g * 4 + j; sa[s / 12] = MFMA32(fr[g & 1][j], qf[s % 12], sa[s / 12]); }
                    __builtin_amdgcn_sched_barrier(0);
                }
            }
            if (k0 + 63 > qw) {
                const int qg = qw + l31;
#pragma unroll
                for (int kb = 0; kb < 2; ++kb)
#pragma unroll
                    for (int i = 0; i < 16; ++i) { const int key = k0 + kb * 32 + (i & 3) + 8 * (i >> 2) + 4 * hh; if (key > qg) sa[kb][i] = -1e30f; }
            }
            float mx = -1e30f;
#pragma unroll
            for (int kb = 0; kb < 2; ++kb)
#pragma unroll
                for (int i = 0; i < 16; ++i) mx = fmaxf(mx, sa[kb][i]);
            mx = fmaxf(mx, __shfl_xor(mx, 32));
            if (__any(mx - m > 6.0f)) {
                const float mnew = fmaxf(m, mx), alpha = __builtin_amdgcn_exp2f(m - mnew); m = mnew; l *= alpha;
#pragma unroll
                for (int d = 0; d < 4; ++d)
#pragma unroll
                    for (int i = 0; i < 16; ++i) o[d][i] *= alpha;
            }
            float ls = 0.f;
#pragma unroll
            for (int kb = 0; kb < 2; ++kb)
#pragma unroll
                for (int i = 0; i < 16; ++i) { const float p = __builtin_amdgcn_exp2f(sa[kb][i] - m); sa[kb][i] = p; ls += p; }
            l += ls;
            bf16x8 pf[4];
#pragma unroll
            for (int kb = 0; kb < 2; ++kb)
#pragma unroll
                for (int s = 0; s < 2; ++s) { u32x4 w; w.x = pk2(sa[kb][8 * s], sa[kb][8 * s + 1]); w.y = pk2(sa[kb][8 * s + 2], sa[kb][8 * s + 3]);
                    w.z = pk2(sa[kb][8 * s + 4], sa[kb][8 * s + 5]); w.w = pk2(sa[kb][8 * s + 6], sa[kb][8 * s + 7]); pf[kb * 2 + s] = __builtin_bit_cast(bf16x8, w); }
            {
                bf16x8 fv[2][4];
#pragma unroll
                for (int j = 0; j < 4; ++j) fv[0][j] = TRV(sb + voff + j * 16 * VROW_B);
                __builtin_amdgcn_sched_barrier(0);
#pragma unroll
                for (int d = 0; d < 4; ++d) {
                    if (d < 3) {
#pragma unroll
                        for (int j = 0; j < 4; ++j) fv[(d + 1) & 1][j] = TRV(sb + voff + (d + 1) * 64 + j * 16 * VROW_B);
                    }
#pragma unroll
                    for (int j = 0; j < 4; ++j) o[d] = MFMA32(fv[d & 1][j], pf[j], o[d]);
                    __builtin_amdgcn_sched_barrier(0);
                }
            }
        }
        if (more) ATT_LSTORE(st ^ 1);
        __syncthreads();
    }
#undef ATT_GLOAD
#undef ATT_LSTORE
    const float inv = __builtin_amdgcn_rcpf(l + __shfl_xor(l, 32));
    bf16_t* orow = AO + (size_t)(b * SEQ + qw + l31) * 1024 + h * 128 + 4 * hh;
#pragma unroll
    for (int d = 0; d < 4; ++d)
#pragma unroll
        for (int g4 = 0; g4 < 4; ++g4) { u32x2 w; w.x = pk2(o[d][4 * g4] * inv, o[d][4 * g4 + 1] * inv); w.y = pk2(o[d][4 * g4 + 2] * inv, o[d][4 * g4 + 3] * inv);
            *(u32x2*)(orow + d * 32 + 8 * g4) = w; }
}
DI void phase_attn(const bf16_t* Q, const bf16_t* Kb, const bf16_t* Vt, bf16_t* AO, LAS unsigned char* lds, int tid, int wave, int lane, const Grp gr) {
    for (int k = gr.mi; k < 64; k += gr.GM) {
        const int pp = gr.grp * 64 + k, bh = pp >> 3, j = pp & 7;
        attn_block(Q, Kb, Vt, AO, lds, bh, 15 - j, tid, wave, lane);
        attn_block(Q, Kb, Vt, AO, lds, bh, j, tid, wave, lane);
    }
}

DI void phase_gmlp(const bf16_t* Z, const float* gv, const float* Ws, const float* bs, bf16_t* GO, LAS unsigned char* lds, int tid, int wave, int lane, const Grp gr) {
    LAS bf16_t* vct = (LAS bf16_t*)lds;
    LAS float* rs = (LAS float*)(lds + 128 * 272);
    const int l31 = lane & 31, hh = lane >> 5, tb = wave >> 1, dh = wave & 1, nks = 2 * (tb + 1);
    for (int it = gr.mi; it < 32; it += gr.GM) {
        const int t0 = (gr.grp * 32 + it) * 128;
        __syncthreads();
#pragma unroll
        for (int rb = 0; rb < 2; ++rb) { u32x4 vv[8][2];
#pragma unroll
            for (int r = 0; r < 8; ++r) { const bf16_t* zr = Z + (size_t)(t0 + wave * 16 + rb * 8 + r) * NINP + ZC_V;
#pragma unroll
                for (int j = 0; j < 2; ++j) vv[r][j] = *(const u32x4*)(zr + (lane + 64 * j) * 8); }
#pragma unroll
            for (int r = 0; r < 8; ++r) { float s = 0.f;
#pragma unroll
                for (int j = 0; j < 2; ++j)
#pragma unroll
                    for (int k = 0; k < 4; ++k) { const float x = gelu_tanh(blo(vv[r][j][k])), y = gelu_tanh(bhi(vv[r][j][k])); s += x * x + y * y; }
                s = wave_sum(s); if (lane == 0) rs[wave * 16 + rb * 8 + r] = rsqrtf(s * (1.f / 1024.f) + EPS); } }
        __syncthreads();
        for (int g = 0; g < 8; ++g) {
            { const int s = tid >> 2, dq = tid & 3; const float r = rs[s]; const bf16_t* zr = Z + (size_t)(t0 + s) * NINP + ZC_V + g * 128 + dq * 32; const float* gp = gv + g * 128 + dq * 32;
#pragma unroll
              for (int c = 0; c < 4; ++c) { const u32x4 a = *(const u32x4*)(zr + 8 * c); const f32x4 g0 = *(const f32x4*)(gp + 8 * c), g1 = *(const f32x4*)(gp + 8 * c + 4);
                  LAS bf16_t* dcol = vct + (dq * 32 + 8 * c) * 136 + s;
                  dcol[0 * 136] = (bf16_t)(pk2(gelu_tanh(blo(a.x)) * r * g0[0], 0.f) & 0xffffu); dcol[1 * 136] = (bf16_t)(pk2(gelu_tanh(bhi(a.x)) * r * g0[1], 0.f) & 0xffffu);
                  dcol[2 * 136] = (bf16_t)(pk2(gelu_tanh(blo(a.y)) * r * g0[2], 0.f) & 0xffffu); dcol[3 * 136] = (bf16_t)(pk2(gelu_tanh(bhi(a.y)) * r * g0[3], 0.f) & 0xffffu);
                  dcol[4 * 136] = (bf16_t)(pk2(gelu_tanh(blo(a.z)) * r * g1[0], 0.f) & 0xffffu); dcol[5 * 136] = (bf16_t)(pk2(gelu_tanh(bhi(a.z)) * r * g1[1], 0.f) & 0xffffu);
                  dcol[6 * 136] = (bf16_t)(pk2(gelu_tanh(blo(a.w)) * r * g1[2], 0.f) & 0xffffu); dcol[7 * 136] = (bf16_t)(pk2(gelu_tanh(bhi(a.w)) * r * g1[3], 0.f) & 0xffffu); } }
            const int t = tb * 32 + l31;
            bf16x8 wf[8];
            { const float* wp = Ws + ((size_t)g * 128 + t) * 128 + 8 * hh;
#pragma unroll
              for (int ks = 0; ks < 8; ++ks) { if (ks < nks) { const f32x4 a = *(const f32x4*)(wp + 16 * ks), c = *(const f32x4*)(wp + 16 * ks + 4); const int s0 = 16 * ks + 8 * hh; float v[8];
#pragma unroll
                      for (int i = 0; i < 4; ++i) { v[i] = (s0 + i <= t) ? a[i] : 0.f; v[4 + i] = (s0 + 4 + i <= t) ? c[i] : 0.f; }
                      u32x4 w; w.x = pk2(v[0], v[1]); w.y = pk2(v[2], v[3]); w.z = pk2(v[4], v[5]); w.w = pk2(v[6], v[7]); wf[ks] = __builtin_bit_cast(bf16x8, w); }
                  else wf[ks] = (bf16x8){0, 0, 0, 0, 0, 0, 0, 0}; } }
            const float bsv = bs[g * 128 + t];
            const bf16_t* ur = Z + (size_t)(t0 + t) * NINP + ZC_U + g * 128 + dh * 64 + 4 * hh;
            u32x2 uv[2][4];
#pragma unroll
            for (int db = 0; db < 2; ++db)
#pragma unroll
                for (int g4 = 0; g4 < 4; ++g4) uv[db][g4] = *(const u32x2*)(ur + db * 32 + 8 * g4);
            __syncthreads();
            f32x16 acc[2];
#pragma unroll
            for (int db = 0; db < 2; ++db) {
#pragma unroll
                for (int i = 0; i < 16; ++i) acc[db][i] = 0.f;
#pragma unroll
                for (int ks = 0; ks < 8; ++ks) if (ks < nks) { const bf16x8 a = *(const LAS bf16x8*)((const LAS unsigned char*)vct + (dh * 64 + db * 32 + l31) * 272 + 32 * ks + 16 * hh); acc[db] = MFMA32(a, wf[ks], acc[db]); }
            }
            bf16_t* orow = GO + (size_t)(t0 + t) * GO_PITCH + g * 128 + dh * 64 + 4 * hh;
#pragma unroll
            for (int db = 0; db < 2; ++db)
#pragma unroll
                for (int g4 = 0; g4 < 4; ++g4) { const u32x2 u = uv[db][g4]; u32x2 w;
                    w.x = pk2(gelu_tanh(blo(u.x)) * (acc[db][4 * g4] + bsv), gelu_tanh(bhi(u.x)) * (acc[db][4 * g4 + 1] + bsv));
                    w.y = pk2(gelu_tanh(blo(u.y)) * (acc[db][4 * g4 + 2] + bsv), gelu_tanh(bhi(u.y)) * (acc[db][4 * g4 + 3] + bsv));
                    *(u32x2*)(orow + db * 32 + 8 * g4) = w; }
            __syncthreads();
        }
    }
}

struct PleOrder {
    int grp, mi, n;
    __device__ __forceinline__ bool next(int i, pg8::Unit& u) const { if (i >= n) return false; u.pm = grp * 16 + (mi - 16); u.pn = i; return true; }
    __device__ __forceinline__ void a_ready(const pg8::Unit&) const {}
    __device__ __forceinline__ void done(const pg8::Unit&) const {}
};
template <class Epi> DI void run_gemm_ple(LAS unsigned char* lds, const bf16_t* A, const bf16_t* Bt, const Epi& E, int tid) {
    pg8::Gemm g; g.A = A; g.Bt = Bt; g.M = T; g.N = DM; g.K = 256; g.lda = 256;
    PleOrder S; S.grp = blockIdx.x & 7; S.mi = blockIdx.x >> 3; { int n8 = S.mi < 16 ? 0 : 8; asm volatile("" : "+s"(n8)); S.n = n8; }
    pg8::gemm_phase<Epi, PleOrder, true, true>((PG8_LAS unsigned char*)lds, g, S, E, tid);
}
DI void fill_rstd_lds(LAS unsigned char* lds, const ssq_t* SS, int grp, int tid, float invn = 1.f / 2048.f) {
    LAS float* rl = (LAS float*)(lds + RL_OFF); const ssq_t* p = SS + (size_t)grp * SEQ;
    for (int i = tid; i < SEQ; i += NTHREADS) rl[i] = rsqrtf(pg8::ssq_to_f(p[i]) * invn + 1e-6f);
    __syncthreads();
}
template <class Epi> DI void run_gemm(LAS unsigned char* lds, const bf16_t* A, const bf16_t* Bt, int N, int K, const Epi& E, int G, int tid, int lda = 0) {
    pg8::Gemm g; g.A = A; g.Bt = Bt; g.M = T; g.N = N; g.K = K; g.lda = lda ? lda : K;
    pg8::StaticOrder S; S.init(T, N, G, (int)blockIdx.x);
    pg8::gemm_phase<Epi, pg8::StaticOrder, true, true>((PG8_LAS unsigned char*)lds, g, S, E, tid);
}

#define PH_BEGIN ArgsP A = args_ptr(); int w_ = wave_s; asm volatile("" : "+s"(w_)); int z_ = 0; asm volatile("" : "+v"(z_)); const int wave = w_, lane = (int)__builtin_amdgcn_mbcnt_hi(~0u, __builtin_amdgcn_mbcnt_lo(~0u, (unsigned)z_)), tid = wave * 64 + lane, G = gridDim.x; unsigned char* ws = A->ws; (void)ws; (void)G;

DI void grid_bar(unsigned* ctr, unsigned target, int tid) {
    asm volatile("s_waitcnt vmcnt(0)" ::: "memory");
    __syncthreads();
    if (tid == 0) {
        __builtin_amdgcn_fence(__ATOMIC_RELEASE, "agent");
        asm volatile("s_waitcnt vmcnt(0)" ::: "memory");
        __hip_atomic_fetch_add(ctr, 1u, __ATOMIC_RELAXED, __HIP_MEMORY_SCOPE_AGENT);
        while (__hip_atomic_load(ctr, __ATOMIC_RELAXED, __HIP_MEMORY_SCOPE_AGENT) < target) __builtin_amdgcn_s_sleep(1);
        __builtin_amdgcn_fence(__ATOMIC_ACQUIRE, "agent");
        asm volatile("s_waitcnt vmcnt(0)" ::: "memory");
    }
    __syncthreads();
}
#define PH_GRP const Grp gr = make_grp(G);
#define VP(S_, BB_) (ws + O_BIG + (size_t)gr.grp * (SLAB - (BB_)) + (S_))
#define GROUP_BAR(k) { PH_BEGIN PH_GRP grid_bar((unsigned*)(ws + O_BAR) + 64 * gr.grp, (unsigned)(k) * (unsigned)gr.GM, tid); }
#define CHIP_BAR(k) { PH_BEGIN grid_bar((unsigned*)(ws + O_BAR) + 64 * 8, (unsigned)(k) * (unsigned)G, tid); }
template <int layer> DI void layer_body(LAS unsigned char* lds, const int wave_s, int& bk) {
    {
        { PH_BEGIN PH_GRP fill_rstd_lds(lds, (const ssq_t*)(ws + O_SS) + (layer * 4 + 0) * T, gr.grp, tid); pg8::EpiSwiglu E; E.O = (bf16_t*)VP(S_ACT, BB_ACT); E.ldc = DFF; E.RL = (const PG8_LAS float*)(lds + RL_OFF);
          run_gemm(lds, layer == 0 ? (const bf16_t*)(ws + O_HB) : (const bf16_t*)VP(S_HBALT, BB_HB), (const bf16_t*)(ws + O_W13A), 2 * DFF, DM, E, G, tid); }
        { PH_BEGIN pg8::EpiBf16<false, true> E; E.O = (bf16_t*)(ws + O_ER); E.ldc = DM; E.RL = nullptr; E.SSout = (ssq_t*)(ws + O_SSE) + layer * T;
          run_gemm_ple(lds, (const bf16_t*)(ws + O_PB), (const bf16_t*)(ws + O_WPLE), E, tid); }
        GROUP_BAR(++bk)
        { PH_BEGIN PH_GRP pg8::EpiResid E; E.Rin = layer == 0 ? (const bf16_t*)(ws + O_HB) : (const bf16_t*)VP(S_HBALT, BB_HB); E.HB = (bf16_t*)(ws + O_HB); E.SSout = (ssq_t*)(ws + O_SS) + (layer * 4 + 1) * T; E.ldc = DM; E.scale = 0.5f;
          run_gemm(lds, (const bf16_t*)VP(S_ACT, BB_ACT), (const bf16_t*)(ws + O_W2A), DM, DFF, E, G, tid); }
        GROUP_BAR(++bk)
        { PH_BEGIN PH_GRP fill_rstd_lds(lds, (const ssq_t*)(ws + O_SS) + (layer * 4 + 1) * T, gr.grp, tid); pg8::EpiZ E; E.O = (bf16_t*)VP(S_Z, BB_Z); E.ldc = NINP; E.RL = (const PG8_LAS float*)(lds + RL_OFF); E.SSq = (ssq_t*)(ws + O_SSQ) + (layer * 2 + 0) * T; E.SSkv = (ssq_t*)(ws + O_SSQ) + (layer * 2 + 1) * T;
          run_gemm(lds, (const bf16_t*)(ws + O_HB), (const bf16_t*)(ws + O_WIN), NINP, DM, E, G, tid); }
        GROUP_BAR(++bk)
        { PH_BEGIN PH_GRP fill_rstd_lds(lds, (const ssq_t*)(ws + O_SSQ) + (layer * 2 + 0) * T, gr.grp, tid, 1.f / 512.f); pg8::EpiBf16<true, false> E; E.O = (bf16_t*)VP(S_QR, BB_QR); E.ldc = 1536; E.RL = (const PG8_LAS float*)(lds + RL_OFF); E.SSout = nullptr;
          run_gemm(lds, (const bf16_t*)VP(S_Z, BB_Z), (const bf16_t*)(ws + O_WUQ), 1536, 512, E, G, tid, NINP); }
        { PH_BEGIN PH_GRP fill_rstd_lds(lds, (const ssq_t*)(ws + O_SSQ) + (layer * 2 + 1) * T, gr.grp, tid, 1.f / 256.f); pg8::EpiBf16<true, false> E; E.O = (bf16_t*)VP(S_KVR, BB_KVR); E.ldc = 2048; E.RL = (const PG8_LAS float*)(lds + RL_OFF); E.SSout = nullptr;
          run_gemm(lds, (const bf16_t*)VP(S_Z, BB_Z) + ZC_KV, (const bf16_t*)(ws + O_WUKV), 2048, 256, E, G, tid, NINP); }
        GROUP_BAR(++bk)
        { PH_BEGIN PH_GRP phase_prep_b((bf16_t*)VP(S_QR, BB_QR), (const bf16_t*)VP(S_KVR, BB_KVR), (const bf16_t*)VP(S_Z, BB_Z), (const int*)A->in[2], A->in[13] + layer * 192, A->in[14] + layer * 192, (bf16_t*)VP(S_KB, BB_KB), (bf16_t*)VP(S_VT, BB_VT), lds, tid, wave, lane, gr); }
        GROUP_BAR(++bk)
        { PH_BEGIN PH_GRP phase_attn((const bf16_t*)VP(S_QR, BB_QR), (const bf16_t*)VP(S_KB, BB_KB), (const bf16_t*)VP(S_KVR, BB_KVR), (bf16_t*)VP(S_VT, BB_VT)  , lds, tid, wave, lane, gr); }
        { PH_BEGIN PH_GRP phase_gmlp((const bf16_t*)VP(S_Z, BB_Z), A->in[15] + layer * 1024, A->in[16] + (size_t)layer * 8 * 128 * 128, A->in[17] + layer * 1024, (bf16_t*)A->out, lds, tid, wave, lane, gr); }
        GROUP_BAR(++bk)
        { PH_BEGIN PH_GRP phase_mixnorm((const bf16_t*)VP(S_VT, BB_VT), (const bf16_t*)A->out, A->in[18] + layer * 1024, A->in[19] + layer * 1024, (bf16_t*)VP(S_MIX, BB_MIX), wave, lane, gr); }
        GROUP_BAR(++bk)
        { PH_BEGIN PH_GRP pg8::EpiResid E; E.Rin = (const bf16_t*)(ws + O_HB); E.HB = (bf16_t*)(ws + O_HB); E.SSout = (ssq_t*)(ws + O_SS) + (layer * 4 + 2) * T; E.ldc = DM; E.scale = 1.f;
          run_gemm(lds, (const bf16_t*)VP(S_MIX, BB_MIX), (const bf16_t*)(ws + O_WOUT), DM, DM, E, G, tid); }
        GROUP_BAR(++bk)
        { PH_BEGIN PH_GRP fill_rstd_lds(lds, (const ssq_t*)(ws + O_SS) + (layer * 4 + 2) * T, gr.grp, tid); pg8::EpiSwiglu E; E.O = (bf16_t*)VP(S_ACT, BB_ACT); E.ldc = DFF; E.RL = (const PG8_LAS float*)(lds + RL_OFF);
          run_gemm(lds, (const bf16_t*)(ws + O_HB), (const bf16_t*)(ws + O_W13B), 2 * DFF, DM, E, G, tid); }
        GROUP_BAR(++bk)
        { PH_BEGIN PH_GRP pg8::EpiResid E; E.Rin = (const bf16_t*)(ws + O_HB); E.HB = (bf16_t*)(ws + O_HB); E.SSout = (ssq_t*)(ws + O_SS) + (layer * 4 + 3) * T; E.ldc = DM; E.scale = 0.5f;
          run_gemm(lds, (const bf16_t*)VP(S_ACT, BB_ACT), (const bf16_t*)(ws + O_W2B), DM, DFF, E, G, tid); }
        GROUP_BAR(++bk)
        { PH_BEGIN PH_GRP pg8::EpiGate<layer == 1> E; E.Rin = (const bf16_t*)(ws + O_HB); E.Hout = A->out; E.E = (const bf16_t*)(ws + O_ER); E.SSin = (const ssq_t*)(ws + O_SS) + (layer * 4 + 3) * T; E.SSE = (const ssq_t*)(ws + O_SSE) + layer * T;
          E.pn = A->in[28] + layer * DM; E.HB = (bf16_t*)VP(S_HBALT, BB_HB); E.SSout = (ssq_t*)(ws + O_SS) + ((layer * 4 + 4) & 7) * T; E.ldc = DM;
          run_gemm(lds, (const bf16_t*)(ws + O_HB), (const bf16_t*)(ws + O_WGATE), DM, DM, E, G, tid); }
    }
}
__global__ void __launch_bounds__(NTHREADS, 2) hybrid_fwd(Args A_unused) {
    extern __shared__ __attribute__((aligned(16))) unsigned char lds_raw[];
    LAS unsigned char* lds = (LAS unsigned char*)lds_raw;
    const int wave_s = __builtin_amdgcn_readfirstlane((int)threadIdx.x >> 6);
    { PH_BEGIN PH_GRP phase_x0(A->in[0], (bf16_t*)(ws + O_HB), (ssq_t*)(ws + O_SS), tid, wave, lane, gr); }
    { PH_BEGIN phase_convert(A, 0, lds, tid, wave, lane, G); }
    cg::this_grid().sync();
    CHIP_BAR(1)
    int bk = 0;
    layer_body<0>(lds, wave_s, bk);
    CHIP_BAR(2)
    { PH_BEGIN phase_convert(A, 1, lds, tid, wave, lane, G); }
    CHIP_BAR(3)
    layer_body<1>(lds, wave_s, bk);
}

extern "C" void kernel_launch(void* const* d_in, const int* in_sizes, int n_in, void* d_out, int out_size, void* d_ws, size_t ws_size, hipStream_t stream) {
    static int grid = 0;
    if (grid == 0) {
        if (n_in != 29 || out_size != T * DM || ws_size < O_END2) { fprintf(stderr, "kernel_launch: unexpected shapes (n_in %d, out %d, ws %zu, need %zu)\n", n_in, out_size, ws_size, (size_t)O_END2); grid = -1; return; }
        int dev = 0, cus = 0, per_cu = 0;
        if (hipGetDevice(&dev) != hipSuccess || hipDeviceGetAttribute(&cus, hipDeviceAttributeMultiprocessorCount, dev) != hipSuccess) { grid = -1; return; }
        if (hipFuncSetAttribute((const void*)hybrid_fwd, hipFuncAttributeMaxDynamicSharedMemorySize, LDS_BYTES) != hipSuccess) { fprintf(stderr, "kernel_launch: hipFuncSetAttribute failed\n"); grid = -1; return; }
        if (hipOccupancyMaxActiveBlocksPerMultiprocessor(&per_cu, (const void*)hybrid_fwd, NTHREADS, LDS_BYTES) != hipSuccess || per_cu < 1) { fprintf(stderr, "kernel_launch: occupancy query says %d blocks per CU\n", per_cu); per_cu = 1; }
        (void)hipGetLastError();
        grid = cus;
        if (grid != 256) { fprintf(stderr, "kernel_launch: built for 256 CUs (8 batch groups of 32 workgroups), found %d\n", cus); grid = -1; return; }
    }
    if (grid < 0) return;
    if (hipMemsetAsync((char*)d_ws + O_BAR, 0, 4096, stream) != hipSuccess) { fprintf(stderr, "kernel_launch: hipMemsetAsync failed\n"); return; }
    Args a{};
    for (int i = 0; i < 29; ++i) a.in[i] = (const float*)d_in[i];
    a.out = (float*)d_out; a.ws = (unsigned char*)d_ws;
    void* args[] = {&a};
    hipError_t e = hipLaunchCooperativeKernel((const void*)hybrid_fwd, dim3(grid), dim3(NTHREADS), args, LDS_BYTES, stream);
    if (e != hipSuccess) fprintf(stderr, "kernel_launch: cooperative launch failed: %s (grid %d)\n", hipGetErrorString(e), grid);
}
```

```cpp
#include <hip/hip_runtime.h>
#include <hip/hip_cooperative_groups.h>
#include <cstdio>
#include <cstdint>
namespace cg = cooperative_groups;
namespace pg8 {
#define PG8_LAS __attribute__((address_space(3)))
typedef unsigned short bf16_t;
typedef short bf16x8 __attribute__((ext_vector_type(8)));
typedef float f32x4 __attribute__((ext_vector_type(4)));
typedef unsigned u32x4 __attribute__((ext_vector_type(4)));
constexpr int BM = 256, BK = 64, HALF = 128, HTB = HALF * BK * 2  , STAGE_BYTES = 8 * HTB, NXCD = 8, WGM = 8;

__host__ __device__ __forceinline__ int lds_byte(int r, int c) { const int st = (r >> 4) * 2 + (c >> 5), rr = r & 15, cc = c & 31, ob = rr * 64 + cc * 2; return st * 1024 + (ob ^ (((ob >> 9) & 1) << 5)); }
__host__ __device__ __forceinline__ void stage_rc(int b, int& R, int& C) { const int st = b / 1024, sb = b % 1024, swz = sb ^ (((sb >> 9) & 1) << 5); R = (st >> 1) * 16 + swz / 64; C = (st & 1) * 32 + (swz % 64) / 2; }
__host__ __device__ __forceinline__ int perm32(int rho) { const int n = rho >> 4, i = rho & 15; return 8 * (i >> 2) + 4 * n + (i & 3); }

struct Unit { int pm, pn; };
struct Gemm { const bf16_t* A; const bf16_t* Bt; int M, N, K, lda; };

struct StaticOrder {
    int nM, nN, nwg, G, c;
    __host__ __device__ void init(int M, int N, int G_, int c_) { nM = M / BM; nN = N / BM; nwg = nM * nN; G = G_; c = c_; }
    __host__ __device__ bool next(int i, Unit& u) const {
        const long L = (long)i * G + c; if (L >= nwg) return false;
        int wgid = (int)L; { const int q = nwg / NXCD, r = nwg % NXCD, xcd = wgid % NXCD, off = wgid / NXCD; wgid = (xcd < r ? xcd * (q + 1) : r * (q + 1) + (xcd - r) * q) + off; }
        const int nig = WGM * nN, gid = wgid / nig, fm = gid * WGM, gsz = (nM - fm) < WGM ? (nM - fm) : WGM;
        u.pm = fm + ((wgid % nig) % gsz); u.pn = (wgid % nig) / gsz; return true;
    }
    __device__ __forceinline__ void a_ready(const Unit&) const {}
    __device__ __forceinline__ void done(const Unit&) const {}
};

typedef float f32x2 __attribute__((ext_vector_type(2)));
typedef __bf16 bf16v2 __attribute__((ext_vector_type(2)));
typedef unsigned u32x2 __attribute__((ext_vector_type(2)));
__device__ __forceinline__ unsigned pk2(float lo, float hi) { f32x2 v = {lo, hi}; return __builtin_bit_cast(unsigned, __builtin_convertvector(v, bf16v2)); }
__device__ __forceinline__ float fast_sigmoid(float x) { return __builtin_amdgcn_rcpf(1.f + __builtin_amdgcn_exp2f(-1.4426950408889634f * x)); }

typedef unsigned long long ssq_t;
constexpr float SSQ_SCALE = 1048576.f, SSQ_INV = 1.f / 1048576.f;
__device__ __forceinline__ float ssq_to_f(ssq_t v) { return ((float)(unsigned)(v >> 32) * 4294967296.f + (float)(unsigned)v) * SSQ_INV; }
__device__ __forceinline__ ssq_t ssq_from_f(float s) { return (ssq_t)(s * SSQ_SCALE); }
__device__ __forceinline__ void row_ss_add(ssq_t* SS, int row, float ss, int fq) { ss += __shfl_xor(ss, 16); ss += __shfl_xor(ss, 32); if (fq == 0) __hip_atomic_fetch_add(SS + row, ssq_from_f(ss), __ATOMIC_RELAXED, __HIP_MEMORY_SCOPE_AGENT); }

template <bool RS, bool ACC> struct EpiBf16 {
    static constexpr bool PERM = true, AFTER_DRAIN = false;
    bf16_t* O; int ldc; const PG8_LAS float* RL; ssq_t* SSout;
    __device__ __forceinline__ void operator()(const f32x4 (&acc)[2][2][4][2], const Unit& u, int wr, int wc, int fr, int fq) const {
        const int row0 = u.pm * BM + wr * 64 + fr, col0 = u.pn * BM + wc * 32 + 8 * fq;
#pragma unroll
        for (int ai = 0; ai < 2; ++ai)
#pragma unroll
            for (int m = 0; m < 4; ++m) { const int row = row0 + ai * HALF + m * 16; bf16_t* rowp = O + (size_t)row * ldc + col0;
                const float r = RS ? RL[row & 4095] : 1.f; float ss = 0.f;
#pragma unroll
                for (int bj = 0; bj < 2; ++bj) { const f32x4 v0 = acc[ai][bj][m][0] * r, v1 = acc[ai][bj][m][1] * r;
                    if (ACC) ss += (v0[0] * v0[0] + v0[1] * v0[1]) + (v0[2] * v0[2] + v0[3] * v0[3]) + (v1[0] * v1[0] + v1[1] * v1[1]) + (v1[2] * v1[2] + v1[3] * v1[3]);
                    u32x4 w; w.x = pk2(v0[0], v0[1]); w.y = pk2(v0[2], v0[3]); w.z = pk2(v1[0], v1[1]); w.w = pk2(v1[2], v1[3]);
                    *(u32x4*)(rowp + bj * HALF) = w; }
                if (ACC) row_ss_add(SSout, row, ss, fq); }
    }
};
struct EpiZ {
    static constexpr bool PERM = true, AFTER_DRAIN = false;
    bf16_t* O; int ldc; const PG8_LAS float* RL; ssq_t* SSq; ssq_t* SSkv;
    __device__ __forceinline__ void operator()(const f32x4 (&acc)[2][2][4][2], const Unit& u, int wr, int wc, int fr, int fq) const {
        const int row0 = u.pm * BM + wr * 64 + fr, col0 = u.pn * BM + wc * 32 + 8 * fq;
        ssq_t* acc_to = u.pn < 2 ? SSq : SSkv; const bool do_acc = u.pn < 3;
#pragma unroll
        for (int ai = 0; ai < 2; ++ai)
#pragma unroll
            for (int m = 0; m < 4; ++m) { const int row = row0 + ai * HALF + m * 16; bf16_t* rowp = O + (size_t)row * ldc + col0;
                const float r = RL[row & 4095]; float ss = 0.f;
#pragma unroll
                for (int bj = 0; bj < 2; ++bj) { const f32x4 v0 = acc[ai][bj][m][0] * r, v1 = acc[ai][bj][m][1] * r;
                    ss += (v0[0] * v0[0] + v0[1] * v0[1]) + (v0[2] * v0[2] + v0[3] * v0[3]) + (v1[0] * v1[0] + v1[1] * v1[1]) + (v1[2] * v1[2] + v1[3] * v1[3]);
                    u32x4 w; w.x = pk2(v0[0], v0[1]); w.y = pk2(v0[2], v0[3]); w.z = pk2(v1[0], v1[1]); w.w = pk2(v1[2], v1[3]);
                    *(u32x4*)(rowp + bj * HALF) = w; }
                if (do_acc) row_ss_add(acc_to, row, ss, fq); }
    }
};
struct EpiSwiglu {
    static constexpr bool PERM = true, AFTER_DRAIN = false;
    bf16_t* O; int ldc; const PG8_LAS float* RL;
    __device__ __forceinline__ void operator()(const f32x4 (&acc)[2][2][4][2], const Unit& u, int wr, int wc, int fr, int fq) const {
        const int row0 = u.pm * BM + wr * 64 + fr, col0 = u.pn * HALF + wc * 32 + 8 * fq;
#pragma unroll
        for (int ai = 0; ai < 2; ++ai)
#pragma unroll
            for (int m = 0; m < 4; ++m) { const int row = row0 + ai * HALF + m * 16; bf16_t* rowp = O + (size_t)row * ldc + col0;
                const float rs = RL[row & 4095];
                float r[8];
#pragma unroll
                for (int n = 0; n < 2; ++n)
#pragma unroll
                    for (int j = 0; j < 4; ++j) { const float a = acc[ai][0][m][n][j] * rs, b = acc[ai][1][m][n][j] * rs; r[n * 4 + j] = a * fast_sigmoid(a) * b; }
                u32x4 w; w.x = pk2(r[0], r[1]); w.y = pk2(r[2], r[3]); w.z = pk2(r[4], r[5]); w.w = pk2(r[6], r[7]);
                *(u32x4*)rowp = w; }
    }
};
__device__ __forceinline__ f32x4 unpack4(u32x2 v) { return (f32x4){__uint_as_float(v.x << 16), __uint_as_float(v.x & 0xffff0000u), __uint_as_float(v.y << 16), __uint_as_float(v.y & 0xffff0000u)}; }
struct EpiResid {
    static constexpr bool PERM = true, AFTER_DRAIN = false;
    const bf16_t* Rin; bf16_t* HB; ssq_t* SSout; int ldc; float scale;
    __device__ __forceinline__ void operator()(const f32x4 (&acc)[2][2][4][2], const Unit& u, int wr, int wc, int fr, int fq) const {
        const int row0 = u.pm * BM + wr * 64 + fr, col0 = u.pn * BM + wc * 32 + 8 * fq;
        u32x4 h[2][4][2];
#pragma unroll
        for (int ai = 0; ai < 2; ++ai)
#pragma unroll
            for (int m = 0; m < 4; ++m) { const size_t off = (size_t)(row0 + ai * HALF + m * 16) * ldc + col0;
#pragma unroll
                for (int bj = 0; bj < 2; ++bj) h[ai][m][bj] = *(const u32x4*)(Rin + off + bj * HALF); }
        asm volatile("" ::: "memory");
#pragma unroll
        for (int ai = 0; ai < 2; ++ai)
#pragma unroll
            for (int m = 0; m < 4; ++m) { const int row = row0 + ai * HALF + m * 16; const size_t off = (size_t)row * ldc + col0; float ss = 0.f;
#pragma unroll
                for (int bj = 0; bj < 2; ++bj) { const u32x4 hv = h[ai][m][bj];
                    const f32x4 o0 = unpack4((u32x2){hv.x, hv.y}) + acc[ai][bj][m][0] * scale, o1 = unpack4((u32x2){hv.z, hv.w}) + acc[ai][bj][m][1] * scale;
                    ss += (o0[0] * o0[0] + o0[1] * o0[1]) + (o0[2] * o0[2] + o0[3] * o0[3]) + (o1[0] * o1[0] + o1[1] * o1[1]) + (o1[2] * o1[2] + o1[3] * o1[3]);
                    u32x4 w; w.x = pk2(o0[0], o0[1]); w.y = pk2(o0[2], o0[3]); w.z = pk2(o1[0], o1[1]); w.w = pk2(o1[2], o1[3]); *(u32x4*)(HB + off + bj * HALF) = w; }
                row_ss_add(SSout, row, ss, fq); }
    }
};
template <bool LAST> struct EpiGate {
    static constexpr bool PERM = true, AFTER_DRAIN = false;
    const bf16_t* Rin; float* Hout; const bf16_t* E; const ssq_t* SSin; const ssq_t* SSE; const float* pn; bf16_t* HB; ssq_t* SSout; int ldc;
    __device__ __forceinline__ void operator()(const f32x4 (&acc)[2][2][4][2], const Unit& u, int wr, int wc, int fr, int fq) const {
        const int row0 = u.pm * BM + wr * 64 + fr, col0 = u.pn * BM + wc * 32 + 8 * fq;
        f32x4 g[2][2];
#pragma unroll
        for (int bj = 0; bj < 2; ++bj)
#pragma unroll
            for (int n = 0; n < 2; ++n) g[bj][n] = *(const f32x4*)(pn + col0 + bj * HALF + n * 4);
#pragma unroll
        for (int ai = 0; ai < 2; ++ai)
#pragma unroll
            for (int mp = 0; mp < 2; ++mp) {
                u32x4 h[2][2], ev[2][2]; ssq_t rh[2], re[2];
#pragma unroll
                for (int mm = 0; mm < 2; ++mm) { const int row = row0 + ai * HALF + (mp * 2 + mm) * 16; const size_t off = (size_t)row * ldc + col0; rh[mm] = SSin[row]; re[mm] = SSE[row];
#pragma unroll
                    for (int bj = 0; bj < 2; ++bj) { h[mm][bj] = *(const u32x4*)(Rin + off + bj * HALF); ev[mm][bj] = *(const u32x4*)(E + off + bj * HALF); } }
                asm volatile("" ::: "memory");
#pragma unroll
                for (int mm = 0; mm < 2; ++mm) { const int m = mp * 2 + mm, row = row0 + ai * HALF + m * 16; const size_t off = (size_t)row * ldc + col0; float ss = 0.f;
                    const float rhv = rsqrtf(ssq_to_f(rh[mm]) * (1.f / 2048.f) + 1e-6f), rev = rsqrtf(ssq_to_f(re[mm]) * (1.f / 2048.f) + 1e-6f);
#pragma unroll
                    for (int bj = 0; bj < 2; ++bj) { f32x4 o[2];
#pragma unroll
                        for (int n = 0; n < 2; ++n) { const f32x4 hv = unpack4(n ? (u32x2){h[mm][bj].z, h[mm][bj].w} : (u32x2){h[mm][bj].x, h[mm][bj].y}), e = unpack4(n ? (u32x2){ev[mm][bj].z, ev[mm][bj].w} : (u32x2){ev[mm][bj].x, ev[mm][bj].y});
                            const f32x4 a = acc[ai][bj][m][n] * rhv; const f32x4 gg = g[bj][n] * rev;
                            o[n][0] = hv[0] + fast_sigmoid(a[0]) * (e[0] * gg[0]); o[n][1] = hv[1] + fast_sigmoid(a[1]) * (e[1] * gg[1]);
                            o[n][2] = hv[2] + fast_sigmoid(a[2]) * (e[2] * gg[2]); o[n][3] = hv[3] + fast_sigmoid(a[3]) * (e[3] * gg[3]); }
                        if (LAST) { *(f32x4*)(Hout + off + bj * HALF) = o[0]; *(f32x4*)(Hout + off + bj * HALF + 4) = o[1]; }
                        else { ss += (o[0][0] * o[0][0] + o[0][1] * o[0][1]) + (o[0][2] * o[0][2] + o[0][3] * o[0][3]) + (o[1][0] * o[1][0] + o[1][1] * o[1][1]) + (o[1][2] * o[1][2] + o[1][3] * o[1][3]);
                            u32x4 w; w.x = pk2(o[0][0], o[0][1]); w.y = pk2(o[0][2], o[0][3]); w.z = pk2(o[1][0], o[1][1]); w.w = pk2(o[1][2], o[1][3]); *(u32x4*)(HB + off + bj * HALF) = w; } }
                    if (!LAST) row_ss_add(SSout, row, ss, fq); }
                asm volatile("" ::: "memory");
            }
    }
};

template <class Epi, class Sched, bool ALIGN_EPI = false, bool SP2 = false>
__device__ __forceinline__ void gemm_phase(PG8_LAS unsigned char* lds, const Gemm g, const Sched& S, const Epi& E, const int tid_in) {
    const int tid = tid_in, wid = __builtin_amdgcn_readfirstlane(tid >> 6), lane = tid & 63, wr = wid >> 2, wc = wid & 3, fr = lane & 15, fq = lane >> 4;
    const int K = g.K, nt = K / BK;
    unsigned voffA[2], voffB[2];
#pragma unroll
    for (int i = 0; i < 2; ++i) { int R, C; stage_rc(tid * 16 + i * 8192, R, C); const int Rb = Epi::PERM ? ((R & ~31) + perm32(R & 31)) : R;
        voffA[i] = (unsigned)(R * g.lda + C) * 2u; voffB[i] = (unsigned)(Rb * K + C) * 2u; }
    const size_t kstep = (size_t)(BK * 2);
    const size_t hstep = (size_t)HALF * K * 2;
    const size_t tstep = 2 * hstep;
    const size_t hstepA = (size_t)HALF * g.lda * 2, tstepA = 2 * hstepA;
    const unsigned ldsw = (unsigned)wid * 1024u;
    const int aoff = lds_byte(wr * 64 + fr, fq * 8), boff = lds_byte(wc * 32 + fr, fq * 8);
#define PG8_SA(b, h) (((b) * 2 + (h)) * HTB)
#define PG8_SB(b, h) ((4 + (b) * 2 + (h)) * HTB)
#define PG8_STAGE(bufoff, gbase, voff) do { _Pragma("unroll") for (int _i = 0; _i < 2; ++_i) \
        __builtin_amdgcn_global_load_lds((const unsigned*)((const char*)(gbase) + (voff)[_i]), (PG8_LAS unsigned*)(lds + (bufoff) + ldsw + _i * 8192), 16, 0, 0); } while (0)
#define PG8_LDA(dst, b, h) do { _Pragma("unroll") for (int m = 0; m < 4; ++m) _Pragma("unroll") for (int k = 0; k < 2; ++k) dst[m][k] = *(const PG8_LAS bf16x8*)(lds + PG8_SA(b, h) + aoff + m * 2048 + k * 1024); } while (0)
#define PG8_LDB(dst, b, h) do { _Pragma("unroll") for (int n = 0; n < 2; ++n) _Pragma("unroll") for (int k = 0; k < 2; ++k) dst[n][k] = *(const PG8_LAS bf16x8*)(lds + PG8_SB(b, h) + boff + n * 2048 + k * 1024); } while (0)
#define PG8_MMA(ai, bj, At, Bt) do { __builtin_amdgcn_s_setprio(1); _Pragma("unroll") for (int m = 0; m < 4; ++m) _Pragma("unroll") for (int n = 0; n < 2; ++n) _Pragma("unroll") for (int k = 0; k < 2; ++k) \
        acc[ai][bj][m][n] = __builtin_amdgcn_mfma_f32_16x16x32_bf16(Bt[n][k], At[m][k], acc[ai][bj][m][n], 0, 0, 0); __builtin_amdgcn_s_setprio(0); } while (0)
#define PG8_WAIT_V(n) asm volatile("s_waitcnt vmcnt(" #n ")" ::: "memory")
#define PG8_WAIT_L(n) asm volatile("s_waitcnt lgkmcnt(" #n ")" ::: "memory")
#define PG8_BAR __builtin_amdgcn_s_barrier()
#define PG8_SCHED __builtin_amdgcn_sched_barrier(0)
    Unit cur, nxt; int ui = 0;
    if (!S.next(0, cur)) return;
    f32x4 acc[2][2][4][2];
#pragma unroll
    for (int a = 0; a < 2; ++a)
#pragma unroll
        for (int b = 0; b < 2; ++b)
#pragma unroll
            for (int m = 0; m < 4; ++m)
#pragma unroll
                for (int n = 0; n < 2; ++n) acc[a][b][m][n] = (f32x4){0.f, 0.f, 0.f, 0.f};
    bf16x8 At[4][2], B0[2][2], B1[2][2];
    const char* cA = (const char*)g.A + (size_t)cur.pm * tstepA; const char* cB = (const char*)g.Bt + (size_t)cur.pn * tstep;
    S.a_ready(cur);
    if constexpr (SP2) {
        PG8_STAGE(PG8_SB(0, 0), cB, voffB); PG8_STAGE(PG8_SB(0, 1), cB + hstep, voffB); PG8_STAGE(PG8_SA(0, 0), cA, voffA); PG8_STAGE(PG8_SA(0, 1), cA + hstepA, voffA);
        if (wr == 1) PG8_BAR;
        PG8_WAIT_V(2); PG8_BAR;
        PG8_STAGE(PG8_SB(1, 0), cB + kstep, voffB); PG8_STAGE(PG8_SA(1, 0), cA + kstep, voffA); PG8_STAGE(PG8_SB(1, 1), cB + hstep + kstep, voffB);
        PG8_WAIT_V(6); PG8_BAR;
    } else {
        PG8_STAGE(PG8_SB(0, 0), cB, voffB); PG8_STAGE(PG8_SA(0, 0), cA, voffA); PG8_STAGE(PG8_SB(0, 1), cB + hstep, voffB); PG8_STAGE(PG8_SA(0, 1), cA + hstepA, voffA);
        if (wr == 1) PG8_BAR;
        PG8_WAIT_V(4); PG8_BAR;
        PG8_STAGE(PG8_SB(1, 0), cB + kstep, voffB); PG8_STAGE(PG8_SA(1, 0), cA + kstep, voffA); PG8_STAGE(PG8_SB(1, 1), cB + hstep + kstep, voffB);
        PG8_WAIT_V(6); PG8_BAR;
    }
    for (;;) {
        const bool has_next = S.next(ui + 1, nxt);
        const char* nA = has_next ? (const char*)g.A + (size_t)nxt.pm * tstepA : cA; const char* nB = has_next ? (const char*)g.Bt + (size_t)nxt.pn * tstep : cB;
        for (int t = 0; t < nt; t += 2) {
            const bool last = (t == nt - 2);
            const char* a1 = cA + (size_t)(t + 1) * kstep;
            const char* a2 = last ? nA : cA + (size_t)(t + 2) * kstep; const char* b2 = last ? nB : cB + (size_t)(t + 2) * kstep;
            const char* a3 = a2 + kstep; const char* b3 = b2 + kstep;
            if (last && has_next) S.a_ready(nxt);
            if constexpr (SP2) {
            PG8_LDB(B0, 0, 0); PG8_LDB(B1, 0, 1); PG8_SCHED; PG8_LDA(At, 0, 0); PG8_STAGE(PG8_SA(1, 1), a1 + hstepA, voffA);
            PG8_WAIT_V(8); PG8_WAIT_L(0); PG8_BAR; PG8_MMA(0, 0, At, B0); PG8_MMA(0, 1, At, B1); PG8_BAR; PG8_SCHED;
            PG8_LDA(At, 0, 1); PG8_STAGE(PG8_SB(0, 0), b2, voffB); PG8_STAGE(PG8_SB(0, 1), b2 + hstep, voffB); PG8_STAGE(PG8_SA(0, 0), a2, voffA);
            PG8_WAIT_V(8); PG8_WAIT_L(0); PG8_BAR; PG8_MMA(1, 0, At, B0); PG8_MMA(1, 1, At, B1); PG8_BAR; PG8_SCHED;
            PG8_LDB(B0, 1, 0); PG8_LDB(B1, 1, 1); PG8_SCHED; PG8_LDA(At, 1, 0); PG8_STAGE(PG8_SA(0, 1), a2 + hstepA, voffA);
            PG8_WAIT_V(8); PG8_WAIT_L(0); PG8_BAR; PG8_MMA(0, 0, At, B0); PG8_MMA(0, 1, At, B1); PG8_BAR; PG8_SCHED;
            PG8_LDA(At, 1, 1); PG8_STAGE(PG8_SB(1, 0), b3, voffB); PG8_STAGE(PG8_SB(1, 1), b3 + hstep, voffB); PG8_STAGE(PG8_SA(1, 0), a3, voffA);
            PG8_WAIT_V(8); PG8_WAIT_L(0); PG8_BAR; PG8_MMA(1, 0, At, B0); PG8_MMA(1, 1, At, B1); PG8_BAR; PG8_SCHED;
            } else {
            PG8_LDB(B0, 0, 0); PG8_SCHED; PG8_LDA(At, 0, 0); PG8_STAGE(PG8_SA(1, 1), a1 + hstepA, voffA);
            PG8_WAIT_L(8); PG8_BAR; PG8_WAIT_L(0); PG8_MMA(0, 0, At, B0); PG8_BAR; PG8_SCHED;
            PG8_LDB(B1, 0, 1); PG8_STAGE(PG8_SB(0, 0), b2, voffB);
            PG8_BAR; PG8_WAIT_L(0); PG8_MMA(0, 1, At, B1); PG8_BAR;
            PG8_LDA(At, 0, 1); PG8_STAGE(PG8_SA(0, 0), a2, voffA);
            PG8_BAR; PG8_WAIT_L(0); PG8_MMA(1, 0, At, B0); PG8_BAR; PG8_SCHED;
            PG8_STAGE(PG8_SB(0, 1), b2 + hstep, voffB);
            PG8_WAIT_V(6); PG8_BAR; PG8_MMA(1, 1, At, B1); PG8_BAR;
            PG8_LDB(B0, 1, 0); PG8_SCHED; PG8_LDA(At, 1, 0); PG8_STAGE(PG8_SA(0, 1), a2 + hstepA, voffA);
            PG8_WAIT_L(8); PG8_BAR; PG8_WAIT_L(0); PG8_MMA(0, 0, At, B0); PG8_BAR; PG8_SCHED;
            PG8_LDB(B1, 1, 1); PG8_STAGE(PG8_SB(1, 0), b3, voffB);
            PG8_BAR; PG8_WAIT_L(0); PG8_MMA(0, 1, At, B1); PG8_BAR;
            PG8_LDA(At, 1, 1); PG8_STAGE(PG8_SA(1, 0), a3, voffA);
            PG8_BAR; PG8_WAIT_L(0); PG8_MMA(1, 0, At, B0); PG8_BAR; PG8_SCHED;
            PG8_STAGE(PG8_SB(1, 1), b3 + hstep, voffB);
            PG8_WAIT_V(6); PG8_BAR; PG8_MMA(1, 1, At, B1); PG8_BAR;
            }
        }
        if constexpr (ALIGN_EPI) { if (wr == 0) PG8_BAR; }
        if constexpr (!Epi::AFTER_DRAIN) { E(acc, cur, wr, wc, fr, fq); S.done(cur); }
        if (!has_next) break;
#pragma unroll
        for (int a = 0; a < 2; ++a)
#pragma unroll
            for (int b = 0; b < 2; ++b)
#pragma unroll
                for (int m = 0; m < 4; ++m)
#pragma unroll
                    for (int n = 0; n < 2; ++n) acc[a][b][m][n] = (f32x4){0.f, 0.f, 0.f, 0.f};
        cur = nxt; cA = nA; cB = nB; ++ui;
        if constexpr (ALIGN_EPI) { if (wr == 1) PG8_BAR; }
    }
    PG8_WAIT_V(0);
    if constexpr (!ALIGN_EPI) { if (wr == 0) PG8_BAR; }
    PG8_BAR;
    if constexpr (Epi::AFTER_DRAIN) { E.fused(acc, cur, wr, wc, fr, fq, lds, wid, lane); S.done(cur); }
#undef PG8_SA
#undef PG8_SB
#undef PG8_STAGE
#undef PG8_LDA
#undef PG8_LDB
#undef PG8_MMA
#undef PG8_WAIT_V
#undef PG8_WAIT_L
#undef PG8_BAR
#undef PG8_SCHED
}
}

#define GAS __attribute__((address_space(1)))
#define LAS __attribute__((address_space(3)))
#define DI __device__ __forceinline__
#define LDS_WAIT() asm volatile("s_waitcnt lgkmcnt(0)" ::: "memory")
using pg8::ssq_t; using pg8::bf16_t; using pg8::bf16x8; using pg8::f32x4; using pg8::u32x4; using pg8::u32x2; using pg8::pk2;
typedef float f32x16 __attribute__((ext_vector_type(16)));

constexpr int T = 32768, DM = 2048, DFF = 5504, NINP = 3072, SEQ = 4096;
constexpr int NWAVES = 8, NTHREADS = 512, LDS_BYTES = 131072 + 16384, RL_OFF = 131072;
constexpr float EPS = 1e-6f;
constexpr int ZC_KV = 512, ZC_ROPE = 768, ZC_U = 832, ZC_V = 1856;
constexpr int GO_PITCH = 4096;

constexpr size_t O_W13A = 0, O_W13B = 45088768, O_W2A = 90177536, O_W2B = 112721920, O_WIN = 135266304, O_WUQ = 147849216, O_WUKV = 149422080, O_WOUT = 150470656, O_WGATE = 158859264, O_WPLE = 167247872;
constexpr size_t O_XN = 168296448, O_ER = O_XN + 134217728, O_PB = O_ER + 134217728, O_BIG = O_PB + 16777216;
constexpr size_t O_ACT = O_BIG, O_Z = O_BIG, O_QR = O_BIG + 201326592, O_KVR = O_QR + 100663296, O_KB = O_KVR + 134217728, O_VT = O_KB + 100663296, O_END = O_VT + 67108864;
constexpr size_t O_CQN = O_KB, O_CKVN = O_VT, O_AO = O_KVR, O_GO = O_KVR + 67108864;
constexpr size_t SLAB = 75497472, S_ACT = 0, S_Z = 0, S_MIX = 0, S_QR = 25165824, S_KVR = S_QR + 12582912, S_AO = S_KVR, S_GO = S_KVR + 8388608, S_KB = S_KVR + 16777216, S_VT = S_KB + 12582912, S_CQN = S_KB, S_CKVN = S_VT, S_HBALT = S_KB;
constexpr size_t BB_ACT = (size_t)SEQ * DFF * 2, BB_Z = (size_t)SEQ * NINP * 2, BB_MIX = (size_t)SEQ * DM * 2, BB_QR = (size_t)SEQ * 1536 * 2, BB_KVR = (size_t)SEQ * 2048 * 2, BB_AO = (size_t)SEQ * 1024 * 2, BB_KB = (size_t)8 * SEQ * 192 * 2, BB_VT = (size_t)8 * 128 * SEQ * 2, BB_CQN = (size_t)SEQ * 512 * 2, BB_CKVN = (size_t)SEQ * 256 * 2, BB_HB = (size_t)SEQ * DM * 2;
static_assert(S_VT + BB_VT == SLAB && S_HBALT + BB_HB <= SLAB && BB_ACT <= SLAB && 8 * SLAB == 603979776, "slab map");
constexpr size_t O_HB = O_XN  , O_HBALT = O_KB  , O_MIX = O_BIG  ;
constexpr size_t O_SS = O_END  , O_SSE = O_SS + 8 * 262144  , O_SSQ = O_SSE + 2 * 262144  , O_BAR = O_SSQ + 4 * 262144  , O_END2 = O_BAR + 4096;

struct Args { const float* in[29]; float* out; unsigned char* ws; };
typedef const __attribute__((address_space(4))) Args* ArgsP;
DI ArgsP args_ptr() { ArgsP p = (ArgsP)__builtin_amdgcn_kernarg_segment_ptr(); asm volatile("" : "+s"(p)); return p; }
DI int fresh_tid() { int t = threadIdx.x; asm volatile("" : "+v"(t)); return t; }
struct Grp { int grp, mi, GM, r0, rstride, rend; };
DI Grp make_grp(int G) { Grp g; g.grp = blockIdx.x & 7; g.mi = blockIdx.x >> 3; g.GM = G >> 3; g.r0 = g.grp * SEQ + g.mi * NWAVES; g.rstride = g.GM * NWAVES; g.rend = (g.grp + 1) * SEQ; return g; }

DI float wave_sum(float v) {
#pragma unroll
    for (int o = 1; o < 64; o <<= 1) v += __shfl_xor(v, o);
    return v;
}
DI float blo(unsigned u) { return __uint_as_float(u << 16); }
DI float bhi(unsigned u) { return __uint_as_float(u & 0xffff0000u); }
DI float gelu_tanh(float x) { const float u = x * (1.f + 0.044715f * x * x); return x * __builtin_amdgcn_rcpf(1.f + __builtin_amdgcn_exp2f(-2.3022081981f * u)); }
DI float dot4(f32x4 v) { return (v[0] * v[0] + v[1] * v[1]) + (v[2] * v[2] + v[3] * v[3]); }

struct CvtD { const float* src; const float* gain; bf16_t* dst; int N, K; };
DI CvtD cvt_mk(const float* W, int K, int N, bf16_t* WT, int mode, int item, const float* gain) {
    const int nblk = N >> 5, kb = item / nblk, nb = item - kb * nblk, k0 = kb * 64, n0 = nb * 32;
    int d0 = n0; if (mode) d0 = (n0 >> 7) * 256 + (n0 & 127) + (mode == 2 ? 128 : 0);
    CvtD d; d.src = W + (size_t)k0 * N + n0; d.gain = gain ? gain + k0 : nullptr; d.dst = WT + (size_t)d0 * K + k0; d.N = N; d.K = K; return d;
}
DI CvtD cvt_desc(ArgsP A, int layer, int it) {
    unsigned char* ws = A->ws;
    constexpr int I_FF = 32 * 172, I_2 = 86 * 64, I_IN = 32 * 90, I_UQ = 8 * 48, I_UKV = 4 * 64, I_SQ = 32 * 64;
    const size_t LFF = (size_t)layer * DM * DFF, LSQ = (size_t)layer * DM * DM;
    int r = it;
    if (r < I_FF) return cvt_mk(A->in[4] + LFF, DM, DFF, (bf16_t*)(ws + O_W13A), 1, r, A->in[3] + layer * DM); r -= I_FF;
    if (r < I_FF) return cvt_mk(A->in[5] + LFF, DM, DFF, (bf16_t*)(ws + O_W13A), 2, r, A->in[3] + layer * DM); r -= I_FF;
    if (r < I_2)  return cvt_mk(A->in[6] + LFF, DFF, DM, (bf16_t*)(ws + O_W2A), 0, r, nullptr); r -= I_2;
    if (r < I_FF) return cvt_mk(A->in[22] + LFF, DM, DFF, (bf16_t*)(ws + O_W13B), 1, r, A->in[21] + layer * DM); r -= I_FF;
    if (r < I_FF) return cvt_mk(A->in[23] + LFF, DM, DFF, (bf16_t*)(ws + O_W13B), 2, r, A->in[21] + layer * DM); r -= I_FF;
    if (r < I_2)  return cvt_mk(A->in[24] + LFF, DFF, DM, (bf16_t*)(ws + O_W2B), 0, r, nullptr); r -= I_2;
    if (r < I_IN) return cvt_mk(A->in[8] + (size_t)layer * DM * 2880, DM, 2880, (bf16_t*)(ws + O_WIN), 0, r, A->in[7] + layer * DM); r -= I_IN;
    if (r < I_UQ) return cvt_mk(A->in[10] + (size_t)layer * 512 * 1536, 512, 1536, (bf16_t*)(ws + O_WUQ), 0, r, A->in[9] + layer * 512); r -= I_UQ;
    if (r < I_UKV) return cvt_mk(A->in[12] + (size_t)layer * 256 * 2048, 256, 2048, (bf16_t*)(ws + O_WUKV), 0, r, A->in[11] + layer * 256); r -= I_UKV;
    if (r < I_SQ) return cvt_mk(A->in[20] + LSQ, DM, DM, (bf16_t*)(ws + O_WOUT), 0, r, nullptr); r -= I_SQ;
    if (r < I_SQ) return cvt_mk(A->in[26] + LSQ, DM, DM, (bf16_t*)(ws + O_WGATE), 0, r, A->in[25] + layer * DM); r -= I_SQ;
    return cvt_mk(A->in[27] + (size_t)layer * 256 * 2048, 256, 2048, (bf16_t*)(ws + O_WPLE), 0, r, nullptr);
}
DI void cvt_load(const CvtD& d, float (&v)[32], int lane) {
    const float* src = d.src + (size_t)(lane >> 3) * d.N + (lane & 7) * 4;
#pragma unroll
    for (int i = 0; i < 8; ++i) { const f32x4 t = *(const f32x4*)(src + (size_t)(8 * i) * d.N); v[4 * i] = t[0]; v[4 * i + 1] = t[1]; v[4 * i + 2] = t[2]; v[4 * i + 3] = t[3]; }
}
DI void cvt_store(const CvtD& d, const float (&v)[32], LAS float* scr, int lane) {
#pragma unroll
    for (int i = 0; i < 8; ++i) { LAS float* p = scr + ((lane >> 3) + 8 * i) * 33 + (lane & 7) * 4; p[0] = v[4 * i]; p[1] = v[4 * i + 1]; p[2] = v[4 * i + 2]; p[3] = v[4 * i + 3]; }
    LDS_WAIT();
    const int c = lane & 7;
    f32x4 g0 = {1.f, 1.f, 1.f, 1.f}, g1 = g0;
    if (d.gain) { g0 = *(const f32x4*)(d.gain + 8 * c); g1 = *(const f32x4*)(d.gain + 8 * c + 4); }
#pragma unroll
    for (int j = 0; j < 4; ++j) { const int n = (lane >> 3) + 8 * j; const LAS float* s = scr + (8 * c) * 33 + n;
        u32x4 o; o.x = pk2(s[0] * g0[0], s[33] * g0[1]); o.y = pk2(s[66] * g0[2], s[99] * g0[3]); o.z = pk2(s[132] * g1[0], s[165] * g1[1]); o.w = pk2(s[198] * g1[2], s[231] * g1[3]);
        *(u32x4*)(d.dst + (size_t)n * d.K + 8 * c) = o; }
    LDS_WAIT();
}
DI void phase_convert(ArgsP A, int layer, LAS unsigned char* lds, int tid, int wave, int lane, int G) {
    LAS float* scr = (LAS float*)(lds + wave * 8448);
    unsigned char* ws = A->ws;
    const int gw = blockIdx.x * NWAVES + wave, NGW = G * NWAVES;
    constexpr int NITEMS = 4 * (32 * 172) + 2 * (86 * 64) + 32 * 90 + 8 * 48 + 4 * 64 + 2 * (32 * 64) + 4 * 64;
    { CvtD nd; float nv[32];
      if (gw < NITEMS) { nd = cvt_desc(A, layer, gw); cvt_load(nd, nv, lane); }
      for (int it = gw; it < NITEMS; it += NGW) {
          const CvtD cd = nd; float cv[32];
#pragma unroll
          for (int i = 0; i < 32; ++i) cv[i] = nv[i];
          if (it + NGW < NITEMS) { nd = cvt_desc(A, layer, it + NGW); cvt_load(nd, nv, lane); }
          cvt_store(cd, cv, scr, lane);
      } }
    const int gt = blockIdx.x * NTHREADS + tid, NGT = G * NTHREADS;
    { u32x4* z = (u32x4*)(ws + O_WIN + (size_t)2880 * DM * 2); const u32x4 zero = {0u, 0u, 0u, 0u};
      for (int i = gt; i < 192 * DM / 8; i += NGT) z[i] = zero; }
    { const f32x4* p = (const f32x4*)(A->in[1] + (size_t)layer * T * 256); u32x4* o = (u32x4*)(ws + O_PB);
      for (int i = gt; i < T * 256 / 8; i += NGT) { const f32x4 a = p[2 * i], b = p[2 * i + 1]; u32x4 w; w.x = pk2(a[0], a[1]); w.y = pk2(a[2], a[3]); w.z = pk2(b[0], b[1]); w.w = pk2(b[2], b[3]); o[i] = w; } }
}

DI void phase_x0(const float* x, bf16_t* HB, ssq_t* SS, int tid, int wave, int lane, const Grp gr) {
    const int gw = gr.r0 + wave, NGW = gr.rstride, REND = gr.rend;
    for (int i = gr.mi * NTHREADS + tid; i < 13 * SEQ; i += gr.GM * NTHREADS) SS[(size_t)(1 + (i >> 12)) * T + gr.grp * SEQ + (i & 4095)] = 0ull;
    for (int row0 = gw; row0 < REND; row0 += 2 * NGW) {
        f32x4 v[2][8];
#pragma unroll
        for (int r = 0; r < 2; ++r) { const int row = row0 + r * NGW; if (row < REND) { const f32x4* xr = (const f32x4*)(x + (size_t)row * DM) + lane;
#pragma unroll
            for (int j = 0; j < 8; ++j) v[r][j] = xr[64 * j]; } }
#pragma unroll
        for (int r = 0; r < 2; ++r) { const int row = row0 + r * NGW; if (row < REND) { float s = 0.f;
#pragma unroll
            for (int j = 0; j < 8; ++j) s += dot4(v[r][j]);
            s = wave_sum(s); if (lane == 0) SS[row] = pg8::ssq_from_f(s);
            u32x2* o = (u32x2*)(HB + (size_t)row * DM) + lane;
#pragma unroll
            for (int j = 0; j < 8; ++j) { u32x2 w; w.x = pk2(v[r][j][0], v[r][j][1]); w.y = pk2(v[r][j][2], v[r][j][3]); o[64 * j] = w; } } }
    }
}
DI void phase_mixnorm(const bf16_t* AO, const bf16_t* GO, const float* ga, const float* gg, bf16_t* XN, int wave, int lane, const Grp gr) {
    const int gw = gr.r0 + wave, NGW = gr.rstride, REND = gr.rend;
    for (int row0 = gw; row0 < REND; row0 += 4 * NGW) {
        u32x4 v[4][2][2];
#pragma unroll
        for (int r = 0; r < 4; ++r) { const int row = row0 + r * NGW; if (row < REND) {
#pragma unroll
            for (int part = 0; part < 2; ++part) { const bf16_t* src = part ? GO + (size_t)row * GO_PITCH : AO + (size_t)row * 1024;
#pragma unroll
                for (int j = 0; j < 2; ++j) v[r][part][j] = *(const u32x4*)(src + (lane + 64 * j) * 8); } } }
#pragma unroll
        for (int r = 0; r < 4; ++r) { const int row = row0 + r * NGW; if (row < REND) {
#pragma unroll
            for (int part = 0; part < 2; ++part) { const float* gn = part ? gg : ga; float s = 0.f;
#pragma unroll
                for (int j = 0; j < 2; ++j)
#pragma unroll
                    for (int k = 0; k < 4; ++k) { const float a = blo(v[r][part][j][k]), b = bhi(v[r][part][j][k]); s += a * a + b * b; }
                const float rstd = rsqrtf(wave_sum(s) * (1.f / 1024.f) + EPS);
#pragma unroll
                for (int j = 0; j < 2; ++j) { const int c0 = (lane + 64 * j) * 8; const f32x4 g0 = *(const f32x4*)(gn + c0), g1 = *(const f32x4*)(gn + c0 + 4); const u32x4 x = v[r][part][j]; u32x4 w;
                    w.x = pk2(blo(x.x) * rstd * g0[0], bhi(x.x) * rstd * g0[1]); w.y = pk2(blo(x.y) * rstd * g0[2], bhi(x.y) * rstd * g0[3]);
                    w.z = pk2(blo(x.z) * rstd * g1[0], bhi(x.z) * rstd * g1[1]); w.w = pk2(blo(x.w) * rstd * g1[2], bhi(x.w) * rstd * g1[3]);
                    *(u32x4*)(XN + (size_t)row * DM + part * 1024 + c0) = w; } } } }
    }
}

DI void norm_rope_store(const LAS float* buf, const LAS float* cs, const float* gain, float scale, bf16_t* dst, size_t hstride, int lane) {
    const int hd8 = lane >> 3, sub = lane & 7;
    const LAS f32x4* p = (const LAS f32x4*)(buf + hd8 * 192 + sub * 24);
    float ss = 0.f;
#pragma unroll
    for (int i = 0; i < 6; ++i) ss += dot4(p[i]);
    ss += __shfl_xor(ss, 1); ss += __shfl_xor(ss, 2); ss += __shfl_xor(ss, 4);
    const float rstd_own = rsqrtf(ss * (1.f / 192.f) + EPS) * scale;
#pragma unroll
    for (int j = 0; j < 3; ++j) {
        const int e0 = (lane + 64 * j) * 8, hd = e0 / 192, d0 = e0 - hd * 192;
        const float rs = __shfl(rstd_own, hd * 8);
        const f32x4 x0 = *(const LAS f32x4*)(buf + e0), x1 = *(const LAS f32x4*)(buf + e0 + 4), g0 = *(const f32x4*)(gain + d0), g1 = *(const f32x4*)(gain + d0 + 4);
        f32x4 v0 = x0 * g0, v1 = x1 * g1;
        if (d0 >= 128) {
            const bool lo = d0 < 160; const int po = lo ? 32 : -32, ci = lo ? d0 - 128 : d0 - 160;
            const f32x4 y0 = *(const LAS f32x4*)(buf + e0 + po), y1 = *(const LAS f32x4*)(buf + e0 + po + 4), h0 = *(const f32x4*)(gain + d0 + po), h1 = *(const f32x4*)(gain + d0 + po + 4);
            const f32x4 c0 = *(const LAS f32x4*)(cs + ci), c1 = *(const LAS f32x4*)(cs + ci + 4), s0 = *(const LAS f32x4*)(cs + 32 + ci), s1 = *(const LAS f32x4*)(cs + 32 + ci + 4);
            const f32x4 p0 = y0 * h0, p1 = y1 * h1;
            if (lo) { v0 = v0 * c0 - p0 * s0; v1 = v1 * c1 - p1 * s1; } else { v0 = v0 * c0 + p0 * s0; v1 = v1 * c1 + p1 * s1; }
        }
        v0 = v0 * rs; v1 = v1 * rs;
        u32x4 w; w.x = pk2(v0[0], v0[1]); w.y = pk2(v0[2], v0[3]); w.z = pk2(v1[0], v1[1]); w.w = pk2(v1[2], v1[3]);
        *(u32x4*)(dst + (size_t)hd * hstride + d0) = w;
    }
}
DI void store8f(LAS float* d, u32x4 a) {
    *(LAS f32x4*)d = (f32x4){blo(a.x), bhi(a.x), blo(a.y), bhi(a.y)}; *(LAS f32x4*)(d + 4) = (f32x4){blo(a.z), bhi(a.z), blo(a.w), bhi(a.w)};
}
DI void phase_prep_b(bf16_t* QR, const bf16_t* KVR, const bf16_t* Z, const int* positions, const float* qn, const float* kn, bf16_t* KB, bf16_t* VT, LAS unsigned char* lds, int tid, int wave, int lane, const Grp gr, const bool do_q = true) {
    LAS float* buf = (LAS float*)(lds + wave * 12544); LAS float* bufk = buf + 1536; LAS float* cs = buf + 3072;
    const int gw = gr.r0 + wave, NGW = gr.rstride, REND = gr.rend;
    const float qscale = 0.07216878364870322f * 1.4426950408889634f;
    double invf = 1.0; { double base = 0.7498942093324558;
#pragma unroll
        for (int bit = 0; bit < 5; ++bit) { if ((lane >> bit) & 1) invf *= base; base *= base; } }
    const float invf32 = (float)invf;
    u32x4 nq[3], nk[3]; int npos = 0;
#define PB_LOAD(tk) do { const bf16_t* qrow_ = QR + (size_t)(tk) * 1536; npos = positions[tk]; \
        _Pragma("unroll") for (int j = 0; j < 3; ++j) { nq[j] = *(const u32x4*)(qrow_ + (lane + 64 * j) * 8); \
            const int c = lane + 64 * j, hd = c / 24, cc = c - hd * 24; \
            const bf16_t* src = cc < 16 ? KVR + (size_t)(tk) * 2048 + hd * 256 + cc * 8 : Z + (size_t)(tk) * NINP + ZC_ROPE + (cc - 16) * 8; nk[j] = *(const u32x4*)src; } } while (0)
    if (gw < REND) PB_LOAD(gw);
    for (int tok = gw; tok < REND; tok += NGW) {
        const int b = tok >> 12, s = tok & 4095;
        u32x4 cq[3], ck[3]; const int pos = npos;
#pragma unroll
        for (int j = 0; j < 3; ++j) { cq[j] = nq[j]; ck[j] = nk[j]; }
        if (tok + NGW < REND) PB_LOAD(tok + NGW);
        if (lane < 32) { const float ang = (float)pos * invf32; double rev = (double)ang * 0.15915494309189535; rev -= __builtin_rint(rev); const float f = (float)rev;
            cs[lane] = __builtin_amdgcn_cosf(f); cs[32 + lane] = __builtin_amdgcn_sinf(f); }
        bf16_t* qrow = QR + (size_t)tok * 1536;
#pragma unroll
        for (int j = 0; j < 3; ++j) { store8f(buf + (lane + 64 * j) * 8, cq[j]); store8f(bufk + (lane + 64 * j) * 8, ck[j]); }
        LDS_WAIT();
        if (do_q) norm_rope_store(buf, cs, qn, qscale, qrow, 192, lane);
        norm_rope_store(bufk, cs, kn, 1.f, KB + ((size_t)(b * 8) * SEQ + s) * 192, (size_t)SEQ * 192, lane);
        LDS_WAIT();
    }
#undef PB_LOAD
}

#define MFMA32(a, b, c) __builtin_amdgcn_mfma_f32_32x32x16_bf16((a), (b), (c), 0, 0, 0)
typedef short s16x4 __attribute__((ext_vector_type(4)));
DI bf16x8 trv_read(const LAS unsigned char* p) {
    const s16x4 lo = __builtin_amdgcn_ds_read_tr16_b64_v4i16((LAS s16x4*)p), hi = __builtin_amdgcn_ds_read_tr16_b64_v4i16((LAS s16x4*)(p + 8 * 320));
    return (bf16x8){lo[0], lo[1], lo[2], lo[3], hi[0], hi[1], hi[2], hi[3]};
}
#define TRV(p) trv_read((const LAS unsigned char*)(p))
constexpr int KROW_B = 400, VROW_B = 320, KT_B = 64 * KROW_B, VT_B = 64 * VROW_B, STG_B = KT_B + VT_B;
DI void attn_block(const bf16_t* Q, const bf16_t* Kb, const bf16_t* Vt, bf16_t* AO, LAS unsigned char* lds, int bh, int qb, int tid, int wave, int lane) {
    const int b = bh >> 3, h = bh & 7, l31 = lane & 31, hh = lane >> 5;
    const int q0 = qb * 256, qw = q0 + wave * 32, nkt = 4 * (qb + 1);
    const bf16_t* Kbase = Kb + (size_t)bh * SEQ * 192; const bf16_t* Vbase = Vt + (size_t)b * SEQ * 2048 + h * 256 + 128;
    bf16x8 qf[12];
    { const bf16_t* qp = Q + (size_t)(b * SEQ + qw + l31) * 1536 + h * 192 + 8 * hh;
#pragma unroll
      for (int s = 0; s < 12; ++s) qf[s] = *(const bf16x8*)(qp + 16 * s); }
    f32x16 o[4];
#pragma unroll
    for (int d = 0; d < 4; ++d)
#pragma unroll
        for (int i = 0; i < 16; ++i) o[d][i] = 0.f;
    float m = -1e30f, l = 0.f;
    const int kgo = (tid >> 3) * 192 + (tid & 7) * 8, klo = (tid >> 3) * KROW_B + (tid & 7) * 16;
    const int vgo = (tid >> 4) * 2048 + (tid & 15) * 8, vlo = KT_B + (tid >> 4) * VROW_B + (tid & 15) * 16;
    u32x4 kr[3], vr[2];
#define ATT_GLOAD(kt) do { _Pragma("unroll") for (int i = 0; i < 3; ++i) kr[i] = *(const u32x4*)(Kbase + (size_t)(kt) * 64 * 192 + kgo + 64 * i); \
        _Pragma("unroll") for (int i = 0; i < 2; ++i) vr[i] = *(const u32x4*)(Vbase + (size_t)(kt) * 64 * 2048 + vgo + 32 * i * 2048); } while (0)
#define ATT_LSTORE(st) do { _Pragma("unroll") for (int i = 0; i < 3; ++i) *(LAS u32x4*)(lds + (st) * STG_B + klo + 128 * i) = kr[i]; \
        _Pragma("unroll") for (int i = 0; i < 2; ++i) *(LAS u32x4*)(lds + (st) * STG_B + vlo + 32 * i * VROW_B) = vr[i]; } while (0)
    ATT_GLOAD(0); ATT_LSTORE(0);
    __syncthreads();
    const int koff = l31 * KROW_B + 16 * hh, voff = KT_B + (4 * hh + ((lane >> 2) & 3)) * VROW_B + (16 * ((lane >> 4) & 1) + 4 * (lane & 3)) * 2;
    for (int kt = 0; kt < nkt; ++kt) {
        const int st = kt & 1, k0 = kt * 64;
        const bool more = kt + 1 < nkt;
        if (more) ATT_GLOAD(kt + 1);
        if (k0 <= qw + 31) {
            const LAS unsigned char* sb = lds + st * STG_B;
            f32x16 sa[2];
#pragma unroll
            for (int kb = 0; kb < 2; ++kb)
#pragma unroll
                for (int i = 0; i < 16; ++i) sa[kb][i] = 0.f;
            {
                bf16x8 fr[2][4];
#pragma unroll
                for (int j = 0; j < 4; ++j) fr[0][j] = *(const LAS bf16x8*)(sb + koff + 32 * j);
                __builtin_amdgcn_sched_barrier(0);
#pragma unroll
                for (int g = 0; g < 6; ++g) {
                    if (g < 5) {
#pragma unroll
                        for (int j = 0; j < 4; ++j) { const int s = (g + 1) * 4 + j; fr[(g + 1) & 1][j] = *(const LAS bf16x8*)(sb + koff + (s / 12) * 32 * KROW_B + 32 * (s % 12)); }
                    }
#pragma unroll
                    for (int j = 0; j < 4; ++j) { const int s = g * 4 + j; sa[s / 12] = MFMA32(fr[g & 1][j], qf[s % 12], sa[s / 12]); }
                    __builtin_amdgcn_sched_barrier(0);
                }
            }
            if (k0 + 63 > qw) {
                const int qg = qw + l31;
#pragma unroll
                for (int kb = 0; kb < 2; ++kb)
#pragma unroll
                    for (int i = 0; i < 16; ++i) { const int key = k0 + kb * 32 + (i & 3) + 8 * (i >> 2) + 4 * hh; if (key > qg) sa[kb][i] = -1e30f; }
            }
            float mx = -1e30f;
#pragma unroll
            for (int kb = 0; kb < 2; ++kb)
#pragma unroll
                for (int i = 0; i < 16; ++i) mx = fmaxf(mx, sa[kb][i]);
            mx = fmaxf(mx, __shfl_xor(mx, 32));
            if (__any(mx - m > 6.0f)) {
                const float mnew = fmaxf(m, mx), alpha = __builtin_amdgcn_exp2f(m - mnew); m = mnew; l *= alpha;
#pragma unroll
                for (int d = 0; d < 4; ++d)
#pragma unroll
                    for (int i = 0; i < 16; ++i) o[d][i] *= alpha;
            }
            float ls = 0.f;
#pragma unroll
            for (int kb = 0; kb < 2; ++kb)
#pragma unroll
                for (int i = 0; i < 16; ++i) { const float p = __builtin_amdgcn_exp2f(sa[kb][i] - m); sa[kb][i] = p; ls += p; }
            l += ls;
            bf16x8 pf[4];
#pragma unroll
            for (int kb = 0; kb < 2; ++kb)
#pragma unroll
                for (int s = 0; s < 2; ++s) { u32x4 w; w.x = pk2(sa[kb][8 * s], sa[kb][8 * s + 1]); w.y = pk2(sa[kb][8 * s + 2], sa[kb][8 * s + 3]);
                    w.z = pk2(sa[kb][8 * s + 4], sa[kb][8 * s + 5]); w.w = pk2(sa[kb][8 * s + 6], sa[kb][8 * s + 7]); pf[kb * 2 + s] = __builtin_bit_cast(bf16x8, w); }
            {
                bf16x8 fv[2][4];
#pragma unroll
                for (int j = 0; j < 4; ++j) fv[0][j] = TRV(sb + voff + j * 16 * VROW_B);
                __builtin_amdgcn_sched_barrier(0);
#pragma unroll
                for (int d = 0; d < 4; ++d) {
                    if (d < 3) {
#pragma unroll
                        for (int j = 0; j < 4; ++j) fv[(d + 1) & 1][j] = TRV(sb + voff + (d + 1) * 64 + j * 16 * VROW_B);
                    }
#pragma unroll
                    for (int j = 0; j < 4; ++j) o[d] = MFMA32(fv[d & 1][j], pf[j], o[d]);
                    __builtin_amdgcn_sched_barrier(0);
                }
            }
        }
        if (more) ATT_LSTORE(st ^ 1);
        __syncthreads();
    }
#undef ATT_GLOAD
#undef ATT_LSTORE
    const float inv = __builtin_amdgcn_rcpf(l + __shfl_xor(l, 32));
    bf16_t* orow = AO + (size_t)(b * SEQ + qw + l31) * 1024 + h * 128 + 4 * hh;
#pragma unroll
    for (int d = 0; d < 4; ++d)
#pragma unroll
        for (int g4 = 0; g4 < 4; ++g4) { u32x2 w; w.x = pk2(o[d][4 * g4] * inv, o[d][4 * g4 + 1] * inv); w.y = pk2(o[d][4 * g4 + 2] * inv, o[d][4 * g4 + 3] * inv);
            *(u32x2*)(orow + d * 32 + 8 * g4) = w; }
}
DI void phase_attn(const bf16_t* Q, const bf16_t* Kb, const bf16_t* Vt, bf16_t* AO, LAS unsigned char* lds, int tid, int wave, int lane, const Grp gr) {
    for (int k = gr.mi; k < 64; k += gr.GM) {
        const int pp = gr.grp * 64 + k, bh = pp >> 3, j = pp & 7;
        attn_block(Q, Kb, Vt, AO, lds, bh, 15 - j, tid, wave, lane);
        attn_block(Q, Kb, Vt, AO, lds, bh, j, tid, wave, lane);
    }
}

DI void phase_gmlp(const bf16_t* Z, const float* gv, const float* Ws, const float* bs, bf16_t* GO, LAS unsigned char* lds, int tid, int wave, int lane, const Grp gr) {
    LAS bf16_t* vct = (LAS bf16_t*)lds;
    LAS float* rs = (LAS float*)(lds + 128 * 272);
    const int l31 = lane & 31, hh = lane >> 5, tb = wave >> 1, dh = wave & 1, nks = 2 * (tb + 1);
    for (int it = gr.mi; it < 32; it += gr.GM) {
        const int t0 = (gr.grp * 32 + it) * 128;
        __syncthreads();
#pragma unroll
        for (int rb = 0; rb < 2; ++rb) { u32x4 vv[8][2];
#pragma unroll
            for (int r = 0; r < 8; ++r) { const bf16_t* zr = Z + (size_t)(t0 + wave * 16 + rb * 8 + r) * NINP + ZC_V;
#pragma unroll
                for (int j = 0; j < 2; ++j) vv[r][j] = *(const u32x4*)(zr + (lane + 64 * j) * 8); }
#pragma unroll
            for (int r = 0; r < 8; ++r) { float s = 0.f;
#pragma unroll
                for (int j = 0; j < 2; ++j)
#pragma unroll
                    for (int k = 0; k < 4; ++k) { const float x = gelu_tanh(blo(vv[r][j][k])), y = gelu_tanh(bhi(vv[r][j][k])); s += x * x + y * y; }
                s = wave_sum(s); if (lane == 0) rs[wave * 16 + rb * 8 + r] = rsqrtf(s * (1.f / 1024.f) + EPS); } }
        __syncthreads();
        for (int g = 0; g < 8; ++g) {
            { const int s = tid >> 2, dq = tid & 3; const float r = rs[s]; const bf16_t* zr = Z + (size_t)(t0 + s) * NINP + ZC_V + g * 128 + dq * 32; const float* gp = gv + g * 128 + dq * 32;
#pragma unroll
              for (int c = 0; c < 4; ++c) { const u32x4 a = *(const u32x4*)(zr + 8 * c); const f32x4 g0 = *(const f32x4*)(gp + 8 * c), g1 = *(const f32x4*)(gp + 8 * c + 4);
                  LAS bf16_t* dcol = vct + (dq * 32 + 8 * c) * 136 + s;
                  dcol[0 * 136] = (bf16_t)(pk2(gelu_tanh(blo(a.x)) * r * g0[0], 0.f) & 0xffffu); dcol[1 * 136] = (bf16_t)(pk2(gelu_tanh(bhi(a.x)) * r * g0[1], 0.f) & 0xffffu);
                  dcol[2 * 136] = (bf16_t)(pk2(gelu_tanh(blo(a.y)) * r * g0[2], 0.f) & 0xffffu); dcol[3 * 136] = (bf16_t)(pk2(gelu_tanh(bhi(a.y)) * r * g0[3], 0.f) & 0xffffu);
                  dcol[4 * 136] = (bf16_t)(pk2(gelu_tanh(blo(a.z)) * r * g1[0], 0.f) & 0xffffu); dcol[5 * 136] = (bf16_t)(pk2(gelu_tanh(bhi(a.z)) * r * g1[1], 0.f) & 0xffffu);
                  dcol[6 * 136] = (bf16_t)(pk2(gelu_tanh(blo(a.w)) * r * g1[2], 0.f) & 0xffffu); dcol[7 * 136] = (bf16_t)(pk2(gelu_tanh(bhi(a.w)) * r * g1[3], 0.f) & 0xffffu); } }
            const int t = tb * 32 + l31;
            bf16x8 wf[8];
            { const float* wp = Ws + ((size_t)g * 128 + t) * 128 + 8 * hh;
#pragma unroll
              for (int ks = 0; ks < 8; ++ks) { if (ks < nks) { const f32x4 a = *(const f32x4*)(wp + 16 * ks), c = *(const f32x4*)(wp + 16 * ks + 4); const int s0 = 16 * ks + 8 * hh; float v[8];
#pragma unroll
                      for (int i = 0; i < 4; ++i) { v[i] = (s0 + i <= t) ? a[i] : 0.f; v[4 + i] = (s0 + 4 + i <= t) ? c[i] : 0.f; }
                      u32x4 w; w.x = pk2(v[0], v[1]); w.y = pk2(v[2], v[3]); w.z = pk2(v[4], v[5]); w.w = pk2(v[6], v[7]); wf[ks] = __builtin_bit_cast(bf16x8, w); }
                  else wf[ks] = (bf16x8){0, 0, 0, 0, 0, 0, 0, 0}; } }
            const float bsv = bs[g * 128 + t];
            const bf16_t* ur = Z + (size_t)(t0 + t) * NINP + ZC_U + g * 128 + dh * 64 + 4 * hh;
            u32x2 uv[2][4];
#pragma unroll
            for (int db = 0; db < 2; ++db)
#pragma unroll
                for (int g4 = 0; g4 < 4; ++g4) uv[db][g4] = *(const u32x2*)(ur + db * 32 + 8 * g4);
            __syncthreads();
            f32x16 acc[2];
#pragma unroll
            for (int db = 0; db < 2; ++db) {
#pragma unroll
                for (int i = 0; i < 16; ++i) acc[db][i] = 0.f;
#pragma unroll
                for (int ks = 0; ks < 8; ++ks) if (ks < nks) { const bf16x8 a = *(const LAS bf16x8*)((const LAS unsigned char*)vct + (dh * 64 + db * 32 + l31) * 272 + 32 * ks + 16 * hh); acc[db] = MFMA32(a, wf[ks], acc[db]); }
            }
            bf16_t* orow = GO + (size_t)(t0 + t) * GO_PITCH + g * 128 + dh * 64 + 4 * hh;
#pragma unroll
            for (int db = 0; db < 2; ++db)
#pragma unroll
                for (int g4 = 0; g4 < 4; ++g4) { const u32x2 u = uv[db][g4]; u32x2 w;
                    w.x = pk2(gelu_tanh(blo(u.x)) * (acc[db][4 * g4] + bsv), gelu_tanh(bhi(u.x)) * (acc[db][4 * g4 + 1] + bsv));
                    w.y = pk2(gelu_tanh(blo(u.y)) * (acc[db][4 * g4 + 2] + bsv), gelu_tanh(bhi(u.y)) * (acc[db][4 * g4 + 3] + bsv));
                    *(u32x2*)(orow + db * 32 + 8 * g4) = w; }
            __syncthreads();
        }
    }
}

struct PleOrder {
    int grp, mi, n;
    __device__ __forceinline__ bool next(int i, pg8::Unit& u) const { if (i >= n) return false; u.pm = grp * 16 + (mi - 16); u.pn = i; return true; }
    __device__ __forceinline__ void a_ready(const pg8::Unit&) const {}
    __device__ __forceinline__ void done(const pg8::Unit&) const {}
};
template <class Epi> DI void run_gemm_ple(LAS unsigned char* lds, const bf16_t* A, const bf16_t* Bt, const Epi& E, int tid) {
    pg8::Gemm g; g.A = A; g.Bt = Bt; g.M = T; g.N = DM; g.K = 256; g.lda = 256;
    PleOrder S; S.grp = blockIdx.x & 7; S.mi = blockIdx.x >> 3; { int n8 = S.mi < 16 ? 0 : 8; asm volatile("" : "+s"(n8)); S.n = n8; }
    pg8::gemm_phase<Epi, PleOrder, true, true>((PG8_LAS unsigned char*)lds, g, S, E, tid);
}
DI void fill_rstd_lds(LAS unsigned char* lds, const ssq_t* SS, int grp, int tid, float invn = 1.f / 2048.f) {
    LAS float* rl = (LAS float*)(lds + RL_OFF); const ssq_t* p = SS + (size_t)grp * SEQ;
    for (int i = tid; i < SEQ; i += NTHREADS) rl[i] = rsqrtf(pg8::ssq_to_f(p[i]) * invn + 1e-6f);
    __syncthreads();
}
template <class Epi> DI void run_gemm(LAS unsigned char* lds, const bf16_t* A, const bf16_t* Bt, int N, int K, const Epi& E, int G, int tid, int lda = 0) {
    pg8::Gemm g; g.A = A; g.Bt = Bt; g.M = T; g.N = N; g.K = K; g.lda = lda ? lda : K;
    pg8::StaticOrder S; S.init(T, N, G, (int)blockIdx.x);
    pg8::gemm_phase<Epi, pg8::StaticOrder, true, true>((PG8_LAS unsigned char*)lds, g, S, E, tid);
}

#define PH_BEGIN ArgsP A = args_ptr(); int w_ = wave_s; asm volatile("" : "+s"(w_)); int z_ = 0; asm volatile("" : "+v"(z_)); const int wave = w_, lane = (int)__builtin_amdgcn_mbcnt_hi(~0u, __builtin_amdgcn_mbcnt_lo(~0u, (unsigned)z_)), tid = wave * 64 + lane, G = gridDim.x; unsigned char* ws = A->ws; (void)ws; (void)G;

DI void grid_bar(unsigned* ctr, unsigned target, int tid) {
    asm volatile("s_waitcnt vmcnt(0)" ::: "memory");
    __syncthreads();
    if (tid == 0) {
        __builtin_amdgcn_fence(__ATOMIC_RELEASE, "agent");
        asm volatile("s_waitcnt vmcnt(0)" ::: "memory");
        __hip_atomic_fetch_add(ctr, 1u, __ATOMIC_RELAXED, __HIP_MEMORY_SCOPE_AGENT);
        while (__hip_atomic_load(ctr, __ATOMIC_RELAXED, __HIP_MEMORY_SCOPE_AGENT) < target) __builtin_amdgcn_s_sleep(1);
        __builtin_amdgcn_fence(__ATOMIC_ACQUIRE, "agent");
        asm volatile("s_waitcnt vmcnt(0)" ::: "memory");
    }
    __syncthreads();
}
#define PH_GRP const Grp gr = make_grp(G);
#define VP(S_, BB_) (ws + O_BIG + (size_t)gr.grp * (SLAB - (BB_)) + (S_))
#define GROUP_BAR(k) { PH_BEGIN PH_GRP grid_bar((unsigned*)(ws + O_BAR) + 64 * gr.grp, (unsigned)(k) * (unsigned)gr.GM, tid); }
#define CHIP_BAR(k) { PH_BEGIN grid_bar((unsigned*)(ws + O_BAR) + 64 * 8, (unsigned)(k) * (unsigned)G, tid); }
template <int layer> DI void layer_body(LAS unsigned char* lds, const int wave_s, int& bk) {
    {
        { PH_BEGIN PH_GRP fill_rstd_lds(lds, (const ssq_t*)(ws + O_SS) + (layer * 4 + 0) * T, gr.grp, tid); pg8::EpiSwiglu E; E.O = (bf16_t*)VP(S_ACT, BB_ACT); E.ldc = DFF; E.RL = (const PG8_LAS float*)(lds + RL_OFF);
          run_gemm(lds, layer == 0 ? (const bf16_t*)(ws + O_HB) : (const bf16_t*)VP(S_HBALT, BB_HB), (const bf16_t*)(ws + O_W13A), 2 * DFF, DM, E, G, tid); }
        { PH_BEGIN pg8::EpiBf16<false, true> E; E.O = (bf16_t*)(ws + O_ER); E.ldc = DM; E.RL = nullptr; E.SSout = (ssq_t*)(ws + O_SSE) + layer * T;
          run_gemm_ple(lds, (const bf16_t*)(ws + O_PB), (const bf16_t*)(ws + O_WPLE), E, tid); }
        GROUP_BAR(++bk)
        { PH_BEGIN PH_GRP pg8::EpiResid E; E.Rin = layer == 0 ? (const bf16_t*)(ws + O_HB) : (const bf16_t*)VP(S_HBALT, BB_HB); E.HB = (bf16_t*)(ws + O_HB); E.SSout = (ssq_t*)(ws + O_SS) + (layer * 4 + 1) * T; E.ldc = DM; E.scale = 0.5f;
          run_gemm(lds, (const bf16_t*)VP(S_ACT, BB_ACT), (const bf16_t*)(ws + O_W2A), DM, DFF, E, G, tid); }
        GROUP_BAR(++bk)
        { PH_BEGIN PH_GRP fill_rstd_lds(lds, (const ssq_t*)(ws + O_SS) + (layer * 4 + 1) * T, gr.grp, tid); pg8::EpiZ E; E.O = (bf16_t*)VP(S_Z, BB_Z); E.ldc = NINP; E.RL = (const PG8_LAS float*)(lds + RL_OFF); E.SSq = (ssq_t*)(ws + O_SSQ) + (layer * 2 + 0) * T; E.SSkv = (ssq_t*)(ws + O_SSQ) + (layer * 2 + 1) * T;
          run_gemm(lds, (const bf16_t*)(ws + O_HB), (const bf16_t*)(ws + O_WIN), NINP, DM, E, G, tid); }
        GROUP_BAR(++bk)
        { PH_BEGIN PH_GRP fill_rstd_lds(lds, (const ssq_t*)(ws + O_SSQ) + (layer * 2 + 0) * T, gr.grp, tid, 1.f / 512.f); pg8::EpiBf16<true, false> E; E.O = (bf16_t*)VP(S_QR, BB_QR); E.ldc = 1536; E.RL = (const PG8_LAS float*)(lds + RL_OFF); E.SSout = nullptr;
          run_gemm(lds, (const bf16_t*)VP(S_Z, BB_Z), (const bf16_t*)(ws + O_WUQ), 1536, 512, E, G, tid, NINP); }
        { PH_BEGIN PH_GRP fill_rstd_lds(lds, (const ssq_t*)(ws + O_SSQ) + (layer * 2 + 1) * T, gr.grp, tid, 1.f / 256.f); pg8::EpiBf16<true, false> E; E.O = (bf16_t*)VP(S_KVR, BB_KVR); E.ldc = 2048; E.RL = (const PG8_LAS float*)(lds + RL_OFF); E.SSout = nullptr;
          run_gemm(lds, (const bf16_t*)VP(S_Z, BB_Z) + ZC_KV, (const bf16_t*)(ws + O_WUKV), 2048, 256, E, G, tid, NINP); }
        GROUP_BAR(++bk)
        { PH_BEGIN PH_GRP phase_prep_b((bf16_t*)VP(S_QR, BB_QR), (const bf16_t*)VP(S_KVR, BB_KVR), (const bf16_t*)VP(S_Z, BB_Z), (const int*)A->in[2], A->in[13] + layer * 192, A->in[14] + layer * 192, (bf16_t*)VP(S_KB, BB_KB), (bf16_t*)VP(S_VT, BB_VT), lds, tid, wave, lane, gr); }
        GROUP_BAR(++bk)
        { PH_BEGIN PH_GRP phase_attn((const bf16_t*)VP(S_QR, BB_QR), (const bf16_t*)VP(S_KB, BB_KB), (const bf16_t*)VP(S_KVR, BB_KVR), (bf16_t*)VP(S_VT, BB_VT)  , lds, tid, wave, lane, gr); }
        { PH_BEGIN PH_GRP phase_gmlp((const bf16_t*)VP(S_Z, BB_Z), A->in[15] + layer * 1024, A->in[16] + (size_t)layer * 8 * 128 * 128, A->in[17] + layer * 1024, (bf16_t*)A->out, lds, tid, wave, lane, gr); }
        GROUP_BAR(++bk)
        { PH_BEGIN PH_GRP phase_mixnorm((const bf16_t*)VP(S_VT, BB_VT), (const bf16_t*)A->out, A->in[18] + layer * 1024, A->in[19] + layer * 1024, (bf16_t*)VP(S_MIX, BB_MIX), wave, lane, gr); }
        GROUP_BAR(++bk)
        { PH_BEGIN PH_GRP pg8::EpiResid E; E.Rin = (const bf16_t*)(ws + O_HB); E.HB = (bf16_t*)(ws + O_HB); E.SSout = (ssq_t*)(ws + O_SS) + (layer * 4 + 2) * T; E.ldc = DM; E.scale = 1.f;
          run_gemm(lds, (const bf16_t*)VP(S_MIX, BB_MIX), (const bf16_t*)(ws + O_WOUT), DM, DM, E, G, tid); }
        GROUP_BAR(++bk)
        { PH_BEGIN PH_GRP fill_rstd_lds(lds, (const ssq_t*)(ws + O_SS) + (layer * 4 + 2) * T, gr.grp, tid); pg8::EpiSwiglu E; E.O = (bf16_t*)VP(S_ACT, BB_ACT); E.ldc = DFF; E.RL = (const PG8_LAS float*)(lds + RL_OFF);
          run_gemm(lds, (const bf16_t*)(ws + O_HB), (const bf16_t*)(ws + O_W13B), 2 * DFF, DM, E, G, tid); }
        GROUP_BAR(++bk)
        { PH_BEGIN PH_GRP pg8::EpiResid E; E.Rin = (const bf16_t*)(ws + O_HB); E.HB = (bf16_t*)(ws + O_HB); E.SSout = (ssq_t*)(ws + O_SS) + (layer * 4 + 3) * T; E.ldc = DM; E.scale = 0.5f;
          run_gemm(lds, (const bf16_t*)VP(S_ACT, BB_ACT), (const bf16_t*)(ws + O_W2B), DM, DFF, E, G, tid); }
        GROUP_BAR(++bk)
        { PH_BEGIN PH_GRP pg8::EpiGate<layer == 1> E; E.Rin = (const bf16_t*)(ws + O_HB); E.Hout = A->out; E.E = (const bf16_t*)(ws + O_ER); E.SSin = (const ssq_t*)(ws + O_SS) + (layer * 4 + 3) * T; E.SSE = (const ssq_t*)(ws + O_SSE) + layer * T;
          E.pn = A->in[28] + layer * DM; E.HB = (bf16_t*)VP(S_HBALT, BB_HB); E.SSout = (ssq_t*)(ws + O_SS) + ((layer * 4 + 4) & 7) * T; E.ldc = DM;
          run_gemm(lds, (const bf16_t*)(ws + O_HB), (const bf16_t*)(ws + O_WGATE), DM, DM, E, G, tid); }
    }
}
__global__ void __launch_bounds__(NTHREADS, 2) hybrid_fwd(Args A_unused) {
    extern __shared__ __attribute__((aligned(16))) unsigned char lds_raw[];
    LAS unsigned char* lds = (LAS unsigned char*)lds_raw;
    const int wave_s = __builtin_amdgcn_readfirstlane((int)threadIdx.x >> 6);
    { PH_BEGIN PH_GRP phase_x0(A->in[0], (bf16_t*)(ws + O_HB), (ssq_t*)(ws + O_SS), tid, wave, lane, gr); }
    { PH_BEGIN phase_convert(A, 0, lds, tid, wave, lane, G); }
    cg::this_grid().sync();
    CHIP_BAR(1)
    int bk = 0;
    layer_body<0>(lds, wave_s, bk);
    CHIP_BAR(2)
    { PH_BEGIN phase_convert(A, 1, lds, tid, wave, lane, G); }
    CHIP_BAR(3)
    layer_body<1>(lds, wave_s, bk);
}

extern "C" void kernel_launch(void* const* d_in, const int* in_sizes, int n_in, void* d_out, int out_size, void* d_ws, size_t ws_size, hipStream_t stream) {
    static int grid = 0;
    if (grid == 0) {
        if (n_in != 29 || out_size != T * DM || ws_size < O_END2) { fprintf(stderr, "kernel_launch: unexpected shapes (n_in %d, out %d, ws %zu, need %zu)\n", n_in, out_size, ws_size, (size_t)O_END2); grid = -1; return; }
        int dev = 0, cus = 0, per_cu = 0;
        if (hipGetDevice(&dev) != hipSuccess || hipDeviceGetAttribute(&cus, hipDeviceAttributeMultiprocessorCount, dev) != hipSuccess) { grid = -1; return; }
        if (hipFuncSetAttribute((const void*)hybrid_fwd, hipFuncAttributeMaxDynamicSharedMemorySize, LDS_BYTES) != hipSuccess) { fprintf(stderr, "kernel_launch: hipFuncSetAttribute failed\n"); grid = -1; return; }
        if (hipOccupancyMaxActiveBlocksPerMultiprocessor(&per_cu, (const void*)hybrid_fwd, NTHREADS, LDS_BYTES) != hipSuccess || per_cu < 1) { fprintf(stderr, "kernel_launch: occupancy query says %d blocks per CU\n", per_cu); per_cu = 1; }
        (void)hipGetLastError();
        grid = cus;
        if (grid != 256) { fprintf(stderr, "kernel_launch: built for 256 CUs (8 batch groups of 32 workgroups), found %d\n", cus); grid = -1; return; }
    }
    if (grid < 0) return;
    if (hipMemsetAsync((char*)d_ws + O_BAR, 0, 4096, stream) != hipSuccess) { fprintf(stderr, "kernel_launch: hipMemsetAsync failed\n"); return; }
    Args a{};
    for (int i = 0; i < 29; ++i) a.in[i] = (const float*)d_in[i];
    a.out = (float*)d_out; a.ws = (unsigned char*)d_ws;
    void* args[] = {&a};
    hipError_t e = hipLaunchCooperativeKernel((const void*)hybrid_fwd, dim3(grid), dim3(NTHREADS), args, LDS_BYTES, stream);
    if (e != hipSuccess) fprintf(stderr, "kernel_launch: cooperative launch failed: %s (grid %d)\n", hipGetErrorString(e), grid);
}
```

```cpp
#include <hip/hip_runtime.h>
#include <hip/hip_cooperative_groups.h>
#include <cstdio>
#include <cstdint>
namespace cg = cooperative_groups;
namespace pg8 {
#define PG8_LAS __attribute__((address_space(3)))
typedef unsigned short bf16_t;
typedef short bf16x8 __attribute__((ext_vector_type(8)));
typedef float f32x4 __attribute__((ext_vector_type(4)));
typedef unsigned u32x4 __attribute__((ext_vector_type(4)));
constexpr int BM = 256, BK = 64, HALF = 128, HTB = HALF * BK * 2  , STAGE_BYTES = 8 * HTB, NXCD = 8, WGM = 8;

__host__ __device__ __forceinline__ int lds_byte(int r, int c) { const int st = (r >> 4) * 2 + (c >> 5), rr = r & 15, cc = c & 31, ob = rr * 64 + cc * 2; return st * 1024 + (ob ^ (((ob >> 9) & 1) << 5)); }
__host__ __device__ __forceinline__ void stage_rc(int b, int& R, int& C) { const int st = b / 1024, sb = b % 1024, swz = sb ^ (((sb >> 9) & 1) << 5); R = (st >> 1) * 16 + swz / 64; C = (st & 1) * 32 + (swz % 64) / 2; }
__host__ __device__ __forceinline__ int perm32(int rho) { const int n = rho >> 4, i = rho & 15; return 8 * (i >> 2) + 4 * n + (i & 3); }

struct Unit { int pm, pn; };
struct Gemm { const bf16_t* A; const bf16_t* Bt; int M, N, K, lda; };

struct StaticOrder {
    int nM, nN, nwg, G, c;
    __host__ __device__ void init(int M, int N, int G_, int c_) { nM = M / BM; nN = N / BM; nwg = nM * nN; G = G_; c = c_; }
    __host__ __device__ bool next(int i, Unit& u) const {
        const long L = (long)i * G + c; if (L >= nwg) return false;
        int wgid = (int)L; { const int q = nwg / NXCD, r = nwg % NXCD, xcd = wgid % NXCD, off = wgid / NXCD; wgid = (xcd < r ? xcd * (q + 1) : r * (q + 1) + (xcd - r) * q) + off; }
        const int nig = WGM * nN, gid = wgid / nig, fm = gid * WGM, gsz = (nM - fm) < WGM ? (nM - fm) : WGM;
        u.pm = fm + ((wgid % nig) % gsz); u.pn = (wgid % nig) / gsz; return true;
    }
    __device__ __forceinline__ void a_ready(const Unit&) const {}
    __device__ __forceinline__ void done(const Unit&) const {}
};

typedef float f32x2 __attribute__((ext_vector_type(2)));
typedef __bf16 bf16v2 __attribute__((ext_vector_type(2)));
typedef unsigned u32x2 __attribute__((ext_vector_type(2)));
__device__ __forceinline__ unsigned pk2(float lo, float hi) { f32x2 v = {lo, hi}; return __builtin_bit_cast(unsigned, __builtin_convertvector(v, bf16v2)); }
__device__ __forceinline__ float fast_sigmoid(float x) { return __builtin_amdgcn_rcpf(1.f + __builtin_amdgcn_exp2f(-1.4426950408889634f * x)); }

typedef unsigned long long ssq_t;
constexpr float SSQ_SCALE = 1048576.f, SSQ_INV = 1.f / 1048576.f;
__device__ __forceinline__ float ssq_to_f(ssq_t v) { return ((float)(unsigned)(v >> 32) * 4294967296.f + (float)(unsigned)v) * SSQ_INV; }
__device__ __forceinline__ ssq_t ssq_from_f(float s) { return (ssq_t)(s * SSQ_SCALE); }
__device__ __forceinline__ void row_ss_add(ssq_t* SS, int row, float ss, int fq) { ss += __shfl_xor(ss, 16); ss += __shfl_xor(ss, 32); if (fq == 0) __hip_atomic_fetch_add(SS + row, ssq_from_f(ss), __ATOMIC_RELAXED, __HIP_MEMORY_SCOPE_AGENT); }

template <bool RS, bool ACC> struct EpiBf16 {
    static constexpr bool PERM = true, AFTER_DRAIN = false;
    bf16_t* O; int ldc; const PG8_LAS float* RL; ssq_t* SSout;
    __device__ __forceinline__ void operator()(const f32x4 (&acc)[2][2][4][2], const Unit& u, int wr, int wc, int fr, int fq) const {
        const int row0 = u.pm * BM + wr * 64 + fr, col0 = u.pn * BM + wc * 32 + 8 * fq;
#pragma unroll
        for (int ai = 0; ai < 2; ++ai)
#pragma unroll
            for (int m = 0; m < 4; ++m) { const int row = row0 + ai * HALF + m * 16; bf16_t* rowp = O + (size_t)row * ldc + col0;
                const float r = RS ? RL[row & 4095] : 1.f; float ss = 0.f;
#pragma unroll
                for (int bj = 0; bj < 2; ++bj) { const f32x4 v0 = acc[ai][bj][m][0] * r, v1 = acc[ai][bj][m][1] * r;
                    if (ACC) ss += (v0[0] * v0[0] + v0[1] * v0[1]) + (v0[2] * v0[2] + v0[3] * v0[3]) + (v1[0] * v1[0] + v1[1] * v1[1]) + (v1[2] * v1[2] + v1[3] * v1[3]);
                    u32x4 w; w.x = pk2(v0[0], v0[1]); w.y = pk2(v0[2], v0[3]); w.z = pk2(v1[0], v1[1]); w.w = pk2(v1[2], v1[3]);
                    *(u32x4*)(rowp + bj * HALF) = w; }
                if (ACC) row_ss_add(SSout, row, ss, fq); }
    }
};
struct EpiZ {
    static constexpr bool PERM = true, AFTER_DRAIN = false;
    bf16_t* O; int ldc; const PG8_LAS float* RL; ssq_t* SSq; ssq_t* SSkv;
    __device__ __forceinline__ void operator()(const f32x4 (&acc)[2][2][4][2], const Unit& u, int wr, int wc, int fr, int fq) const {
        const int row0 = u.pm * BM + wr * 64 + fr, col0 = u.pn * BM + wc * 32 + 8 * fq;
        ssq_t* acc_to = u.pn < 2 ? SSq : SSkv; const bool do_acc = u.pn < 3;
#pragma unroll
        for (int ai = 0; ai < 2; ++ai)
#pragma unroll
            for (int m = 0; m < 4; ++m) { const int row = row0 + ai * HALF + m * 16; bf16_t* rowp = O + (size_t)row * ldc + col0;
                const float r = RL[row & 4095]; float ss = 0.f;
#pragma unroll
                for (int bj = 0; bj < 2; ++bj) { const f32x4 v0 = acc[ai][bj][m][0] * r, v1 = acc[ai][bj][m][1] * r;
                    ss += (v0[0] * v0[0] + v0[1] * v0[1]) + (v0[2] * v0[2] + v0[3] * v0[3]) + (v1[0] * v1[0] + v1[1] * v1[1]) + (v1[2] * v1[2] + v1[3] * v1[3]);
                    u32x4 w; w.x = pk2(v0[0], v0[1]); w.y = pk2(v0[2], v0[3]); w.z = pk2(v1[0], v1[1]); w.w = pk2(v1[2], v1[3]);
                    *(u32x4*)(rowp + bj * HALF) = w; }
                if (do_acc) row_ss_add(acc_to, row, ss, fq); }
    }
};
struct EpiSwiglu {
    static constexpr bool PERM = true, AFTER_DRAIN = false;
    bf16_t* O; int ldc; const PG8_LAS float* RL;
    __device__ __forceinline__ void operator()(const f32x4 (&acc)[2][2][4][2], const Unit& u, int wr, int wc, int fr, int fq) const {
        const int row0 = u.pm * BM + wr * 64 + fr, col0 = u.pn * HALF + wc * 32 + 8 * fq;
#pragma unroll
        for (int ai = 0; ai < 2; ++ai)
#pragma unroll
            for (int m = 0; m < 4; ++m) { const int row = row0 + ai * HALF + m * 16; bf16_t* rowp = O + (size_t)row * ldc + col0;
                const float rs = RL[row & 4095];
                float r[8];
#pragma unroll
                for (int n = 0; n < 2; ++n)
#pragma unroll
                    for (int j = 0; j < 4; ++j) { const float a = acc[ai][0][m][n][j] * rs, b = acc[ai][1][m][n][j] * rs; r[n * 4 + j] = a * fast_sigmoid(a) * b; }
                u32x4 w; w.x = pk2(r[0], r[1]); w.y = pk2(r[2], r[3]); w.z = pk2(r[4], r[5]); w.w = pk2(r[6], r[7]);
                *(u32x4*)rowp = w; }
    }
};
__device__ __forceinline__ f32x4 unpack4(u32x2 v) { return (f32x4){__uint_as_float(v.x << 16), __uint_as_float(v.x & 0xffff0000u), __uint_as_float(v.y << 16), __uint_as_float(v.y & 0xffff0000u)}; }
struct EpiResid {
    static constexpr bool PERM = true, AFTER_DRAIN = false;
    const bf16_t* Rin; bf16_t* HB; ssq_t* SSout; int ldc; float scale;
    __device__ __forceinline__ void operator()(const f32x4 (&acc)[2][2][4][2], const Unit& u, int wr, int wc, int fr, int fq) const {
        const int row0 = u.pm * BM + wr * 64 + fr, col0 = u.pn * BM + wc * 32 + 8 * fq;
        u32x4 h[2][4][2];
#pragma unroll
        for (int ai = 0; ai < 2; ++ai)
#pragma unroll
            for (int m = 0; m < 4; ++m) { const size_t off = (size_t)(row0 + ai * HALF + m * 16) * ldc + col0;
#pragma unroll
                for (int bj = 0; bj < 2; ++bj) h[ai][m][bj] = *(const u32x4*)(Rin + off + bj * HALF); }
        asm volatile("" ::: "memory");
#pragma unroll
        for (int ai = 0; ai < 2; ++ai)
#pragma unroll
            for (int m = 0; m < 4; ++m) { const int row = row0 + ai * HALF + m * 16; const size_t off = (size_t)row * ldc + col0; float ss = 0.f;
#pragma unroll
                for (int bj = 0; bj < 2; ++bj) { const u32x4 hv = h[ai][m][bj];
                    const f32x4 o0 = unpack4((u32x2){hv.x, hv.y}) + acc[ai][bj][m][0] * scale, o1 = unpack4((u32x2){hv.z, hv.w}) + acc[ai][bj][m][1] * scale;
                    ss += (o0[0] * o0[0] + o0[1] * o0[1]) + (o0[2] * o0[2] + o0[3] * o0[3]) + (o1[0] * o1[0] + o1[1] * o1[1]) + (o1[2] * o1[2] + o1[3] * o1[3]);
                    u32x4 w; w.x = pk2(o0[0], o0[1]); w.y = pk2(o0[2], o0[3]); w.z = pk2(o1[0], o1[1]); w.w = pk2(o1[2], o1[3]); *(u32x4*)(HB + off + bj * HALF) = w; }
                row_ss_add(SSout, row, ss, fq); }
    }
};
template <bool LAST> struct EpiGate {
    static constexpr bool PERM = true, AFTER_DRAIN = false;
    const bf16_t* Rin; float* Hout; const bf16_t* E; const ssq_t* SSin; const ssq_t* SSE; const float* pn; bf16_t* HB; ssq_t* SSout; int ldc;
    __device__ __forceinline__ void operator()(const f32x4 (&acc)[2][2][4][2], const Unit& u, int wr, int wc, int fr, int fq) const {
        const int row0 = u.pm * BM + wr * 64 + fr, col0 = u.pn * BM + wc * 32 + 8 * fq;
        f32x4 g[2][2];
#pragma unroll
        for (int bj = 0; bj < 2; ++bj)
#pragma unroll
            for (int n = 0; n < 2; ++n) g[bj][n] = *(const f32x4*)(pn + col0 + bj * HALF + n * 4);
#pragma unroll
        for (int ai = 0; ai < 2; ++ai)
#pragma unroll
            for (int mp = 0; mp < 2; ++mp) {
                u32x4 h[2][2], ev[2][2]; ssq_t rh[2], re[2];
#pragma unroll
                for (int mm = 0; mm < 2; ++mm) { const int row = row0 + ai * HALF + (mp * 2 + mm) * 16; const size_t off = (size_t)row * ldc + col0; rh[mm] = SSin[row]; re[mm] = SSE[row];
#pragma unroll
                    for (int bj = 0; bj < 2; ++bj) { h[mm][bj] = *(const u32x4*)(Rin + off + bj * HALF); ev[mm][bj] = *(const u32x4*)(E + off + bj * HALF); } }
                asm volatile("" ::: "memory");
#pragma unroll
                for (int mm = 0; mm < 2; ++mm) { const int m = mp * 2 + mm, row = row0 + ai * HALF + m * 16; const size_t off = (size_t)row * ldc + col0; float ss = 0.f;
                    const float rhv = rsqrtf(ssq_to_f(rh[mm]) * (1.f / 2048.f) + 1e-6f), rev = rsqrtf(ssq_to_f(re[mm]) * (1.f / 2048.f) + 1e-6f);
#pragma unroll
                    for (int bj = 0; bj < 2; ++bj) { f32x4 o[2];
#pragma unroll
                        for (int n = 0; n < 2; ++n) { const f32x4 hv = unpack4(n ? (u32x2){h[mm][bj].z, h[mm][bj].w} : (u32x2){h[mm][bj].x, h[mm][bj].y}), e = unpack4(n ? (u32x2){ev[mm][bj].z, ev[mm][bj].w} : (u32x2){ev[mm][bj].x, ev[mm][bj].y});
                            const f32x4 a = acc[ai][bj][m][n] * rhv; const f32x4 gg = g[bj][n] * rev;
                            o[n][0] = hv[0] + fast_sigmoid(a[0]) * (e[0] * gg[0]); o[n][1] = hv[1] + fast_sigmoid(a[1]) * (e[1] * gg[1]);
                            o[n][2] = hv[2] + fast_sigmoid(a[2]) * (e[2] * gg[2]); o[n][3] = hv[3] + fast_sigmoid(a[3]) * (e[3] * gg[3]); }
                        if (LAST) { __builtin_nontemporal_store(o[0], (f32x4*)(Hout + off + bj * HALF)); __builtin_nontemporal_store(o[1], (f32x4*)(Hout + off + bj * HALF + 4)); }
                        else { ss += (o[0][0] * o[0][0] + o[0][1] * o[0][1]) + (o[0][2] * o[0][2] + o[0][3] * o[0][3]) + (o[1][0] * o[1][0] + o[1][1] * o[1][1]) + (o[1][2] * o[1][2] + o[1][3] * o[1][3]);
                            u32x4 w; w.x = pk2(o[0][0], o[0][1]); w.y = pk2(o[0][2], o[0][3]); w.z = pk2(o[1][0], o[1][1]); w.w = pk2(o[1][2], o[1][3]); *(u32x4*)(HB + off + bj * HALF) = w; } }
                    if (!LAST) row_ss_add(SSout, row, ss, fq); }
                asm volatile("" ::: "memory");
            }
    }
};

template <class Epi, class Sched, bool ALIGN_EPI = false, bool SP2 = false>
__device__ __forceinline__ void gemm_phase(PG8_LAS unsigned char* lds, const Gemm g, const Sched& S, const Epi& E, const int tid_in) {
    const int tid = tid_in, wid = __builtin_amdgcn_readfirstlane(tid >> 6), lane = tid & 63, wr = wid >> 2, wc = wid & 3, fr = lane & 15, fq = lane >> 4;
    const int K = g.K, nt = K / BK;
    unsigned voffA[2], voffB[2];
#pragma unroll
    for (int i = 0; i < 2; ++i) { int R, C; stage_rc(tid * 16 + i * 8192, R, C); const int Rb = Epi::PERM ? ((R & ~31) + perm32(R & 31)) : R;
        voffA[i] = (unsigned)(R * g.lda + C) * 2u; voffB[i] = (unsigned)(Rb * K + C) * 2u; }
    const size_t kstep = (size_t)(BK * 2);
    const size_t hstep = (size_t)HALF * K * 2;
    const size_t tstep = 2 * hstep;
    const size_t hstepA = (size_t)HALF * g.lda * 2, tstepA = 2 * hstepA;
    const unsigned ldsw = (unsigned)wid * 1024u;
    const int aoff = lds_byte(wr * 64 + fr, fq * 8), boff = lds_byte(wc * 32 + fr, fq * 8);
#define PG8_SA(b, h) (((b) * 2 + (h)) * HTB)
#define PG8_SB(b, h) ((4 + (b) * 2 + (h)) * HTB)
#define PG8_STAGE(bufoff, gbase, voff) do { _Pragma("unroll") for (int _i = 0; _i < 2; ++_i) \
        __builtin_amdgcn_global_load_lds((const unsigned*)((const char*)(gbase) + (voff)[_i]), (PG8_LAS unsigned*)(lds + (bufoff) + ldsw + _i * 8192), 16, 0, 0); } while (0)
#define PG8_LDA(dst, b, h) do { _Pragma("unroll") for (int m = 0; m < 4; ++m) _Pragma("unroll") for (int k = 0; k < 2; ++k) dst[m][k] = *(const PG8_LAS bf16x8*)(lds + PG8_SA(b, h) + aoff + m * 2048 + k * 1024); } while (0)
#define PG8_LDB(dst, b, h) do { _Pragma("unroll") for (int n = 0; n < 2; ++n) _Pragma("unroll") for (int k = 0; k < 2; ++k) dst[n][k] = *(const PG8_LAS bf16x8*)(lds + PG8_SB(b, h) + boff + n * 2048 + k * 1024); } while (0)
#define PG8_MMA(ai, bj, At, Bt) do { __builtin_amdgcn_s_setprio(1); _Pragma("unroll") for (int m = 0; m < 4; ++m) _Pragma("unroll") for (int n = 0; n < 2; ++n) _Pragma("unroll") for (int k = 0; k < 2; ++k) \
        acc[ai][bj][m][n] = __builtin_amdgcn_mfma_f32_16x16x32_bf16(Bt[n][k], At[m][k], acc[ai][bj][m][n], 0, 0, 0); __builtin_amdgcn_s_setprio(0); } while (0)
#define PG8_WAIT_V(n) asm volatile("s_waitcnt vmcnt(" #n ")" ::: "memory")
#define PG8_WAIT_L(n) asm volatile("s_waitcnt lgkmcnt(" #n ")" ::: "memory")
#define PG8_BAR __builtin_amdgcn_s_barrier()
#define PG8_SCHED __builtin_amdgcn_sched_barrier(0)
    Unit cur, nxt; int ui = 0;
    if (!S.next(0, cur)) return;
    f32x4 acc[2][2][4][2];
#pragma unroll
    for (int a = 0; a < 2; ++a)
#pragma unroll
        for (int b = 0; b < 2; ++b)
#pragma unroll
            for (int m = 0; m < 4; ++m)
#pragma unroll
                for (int n = 0; n < 2; ++n) acc[a][b][m][n] = (f32x4){0.f, 0.f, 0.f, 0.f};
    bf16x8 At[4][2], B0[2][2], B1[2][2];
    const char* cA = (const char*)g.A + (size_t)cur.pm * tstepA; const char* cB = (const char*)g.Bt + (size_t)cur.pn * tstep;
    S.a_ready(cur);
    if constexpr (SP2) {
        PG8_STAGE(PG8_SB(0, 0), cB, voffB); PG8_STAGE(PG8_SB(0, 1), cB + hstep, voffB); PG8_STAGE(PG8_SA(0, 0), cA, voffA); PG8_STAGE(PG8_SA(0, 1), cA + hstepA, voffA);
        if (wr == 1) PG8_BAR;
        PG8_WAIT_V(2); PG8_BAR;
        PG8_STAGE(PG8_SB(1, 0), cB + kstep, voffB); PG8_STAGE(PG8_SA(1, 0), cA + kstep, voffA); PG8_STAGE(PG8_SB(1, 1), cB + hstep + kstep, voffB);
        PG8_WAIT_V(6); PG8_BAR;
    } else {
        PG8_STAGE(PG8_SB(0, 0), cB, voffB); PG8_STAGE(PG8_SA(0, 0), cA, voffA); PG8_STAGE(PG8_SB(0, 1), cB + hstep, voffB); PG8_STAGE(PG8_SA(0, 1), cA + hstepA, voffA);
        if (wr == 1) PG8_BAR;
        PG8_WAIT_V(4); PG8_BAR;
        PG8_STAGE(PG8_SB(1, 0), cB + kstep, voffB); PG8_STAGE(PG8_SA(1, 0), cA + kstep, voffA); PG8_STAGE(PG8_SB(1, 1), cB + hstep + kstep, voffB);
        PG8_WAIT_V(6); PG8_BAR;
    }
    for (;;) {
        const bool has_next = S.next(ui + 1, nxt);
        const char* nA = has_next ? (const char*)g.A + (size_t)nxt.pm * tstepA : cA; const char* nB = has_next ? (const char*)g.Bt + (size_t)nxt.pn * tstep : cB;
        for (int t = 0; t < nt; t += 2) {
            const bool last = (t == nt - 2);
            const char* a1 = cA + (size_t)(t + 1) * kstep;
            const char* a2 = last ? nA : cA + (size_t)(t + 2) * kstep; const char* b2 = last ? nB : cB + (size_t)(t + 2) * kstep;
            const char* a3 = a2 + kstep; const char* b3 = b2 + kstep;
            if (last && has_next) S.a_ready(nxt);
            if constexpr (SP2) {
            PG8_LDB(B0, 0, 0); PG8_LDB(B1, 0, 1); PG8_SCHED; PG8_LDA(At, 0, 0); PG8_STAGE(PG8_SA(1, 1), a1 + hstepA, voffA);
            PG8_WAIT_V(8); PG8_WAIT_L(0); PG8_BAR; PG8_MMA(0, 0, At, B0); PG8_MMA(0, 1, At, B1); PG8_BAR; PG8_SCHED;
            PG8_LDA(At, 0, 1); PG8_STAGE(PG8_SB(0, 0), b2, voffB); PG8_STAGE(PG8_SB(0, 1), b2 + hstep, voffB); PG8_STAGE(PG8_SA(0, 0), a2, voffA);
            PG8_WAIT_V(8); PG8_WAIT_L(0); PG8_BAR; PG8_MMA(1, 0, At, B0); PG8_MMA(1, 1, At, B1); PG8_BAR; PG8_SCHED;
            PG8_LDB(B0, 1, 0); PG8_LDB(B1, 1, 1); PG8_SCHED; PG8_LDA(At, 1, 0); PG8_STAGE(PG8_SA(0, 1), a2 + hstepA, voffA);
            PG8_WAIT_V(8); PG8_WAIT_L(0); PG8_BAR; PG8_MMA(0, 0, At, B0); PG8_MMA(0, 1, At, B1); PG8_BAR; PG8_SCHED;
            PG8_LDA(At, 1, 1); PG8_STAGE(PG8_SB(1, 0), b3, voffB); PG8_STAGE(PG8_SB(1, 1), b3 + hstep, voffB); PG8_STAGE(PG8_SA(1, 0), a3, voffA);
            PG8_WAIT_V(8); PG8_WAIT_L(0); PG8_BAR; PG8_MMA(1, 0, At, B0); PG8_MMA(1, 1, At, B1); PG8_BAR; PG8_SCHED;
            } else {
            PG8_LDB(B0, 0, 0); PG8_SCHED; PG8_LDA(At, 0, 0); PG8_STAGE(PG8_SA(1, 1), a1 + hstepA, voffA);
            PG8_WAIT_L(8); PG8_BAR; PG8_WAIT_L(0); PG8_MMA(0, 0, At, B0); PG8_BAR; PG8_SCHED;
            PG8_LDB(B1, 0, 1); PG8_STAGE(PG8_SB(0, 0), b2, voffB);
            PG8_BAR; PG8_WAIT_L(0); PG8_MMA(0, 1, At, B1); PG8_BAR;
            PG8_LDA(At, 0, 1); PG8_STAGE(PG8_SA(0, 0), a2, voffA);
            PG8_BAR; PG8_WAIT_L(0); PG8_MMA(1, 0, At, B0); PG8_BAR; PG8_SCHED;
            PG8_STAGE(PG8_SB(0, 1), b2 + hstep, voffB);
            PG8_WAIT_V(6); PG8_BAR; PG8_MMA(1, 1, At, B1); PG8_BAR;
            PG8_LDB(B0, 1, 0); PG8_SCHED; PG8_LDA(At, 1, 0); PG8_STAGE(PG8_SA(0, 1), a2 + hstepA, voffA);
            PG8_WAIT_L(8); PG8_BAR; PG8_WAIT_L(0); PG8_MMA(0, 0, At, B0); PG8_BAR; PG8_SCHED;
            PG8_LDB(B1, 1, 1); PG8_STAGE(PG8_SB(1, 0), b3, voffB);
            PG8_BAR; PG8_WAIT_L(0); PG8_MMA(0, 1, At, B1); PG8_BAR;
            PG8_LDA(At, 1, 1); PG8_STAGE(PG8_SA(1, 0), a3, voffA);
            PG8_BAR; PG8_WAIT_L(0); PG8_MMA(1, 0, At, B0); PG8_BAR; PG8_SCHED;
            PG8_STAGE(PG8_SB(1, 1), b3 + hstep, voffB);
            PG8_WAIT_V(6); PG8_BAR; PG8_MMA(1, 1, At, B1); PG8_BAR;
            }
        }
        if constexpr (ALIGN_EPI) { if (wr == 0) PG8_BAR; }
        if constexpr (!Epi::AFTER_DRAIN) { E(acc, cur, wr, wc, fr, fq); S.done(cur); }
        if (!has_next) break;
#pragma unroll
        for (int a = 0; a < 2; ++a)
#pragma unroll
            for (int b = 0; b < 2; ++b)
#pragma unroll
                for (int m = 0; m < 4; ++m)
#pragma unroll
                    for (int n = 0; n < 2; ++n) acc[a][b][m][n] = (f32x4){0.f, 0.f, 0.f, 0.f};
        cur = nxt; cA = nA; cB = nB; ++ui;
        if constexpr (ALIGN_EPI) { if (wr == 1) PG8_BAR; }
    }
    PG8_WAIT_V(0);
    if constexpr (!ALIGN_EPI) { if (wr == 0) PG8_BAR; }
    PG8_BAR;
    if constexpr (Epi::AFTER_DRAIN) { E.fused(acc, cur, wr, wc, fr, fq, lds, wid, lane); S.done(cur); }
#undef PG8_SA
#undef PG8_SB
#undef PG8_STAGE
#undef PG8_LDA
#undef PG8_LDB
#undef PG8_MMA
#undef PG8_WAIT_V
#undef PG8_WAIT_L
#undef PG8_BAR
#undef PG8_SCHED
}
}

#define GAS __attribute__((address_space(1)))
#define LAS __attribute__((address_space(3)))
#define DI __device__ __forceinline__
#define LDS_WAIT() asm volatile("s_waitcnt lgkmcnt(0)" ::: "memory")
using pg8::ssq_t; using pg8::bf16_t; using pg8::bf16x8; using pg8::f32x4; using pg8::u32x4; using pg8::u32x2; using pg8::pk2;
typedef float f32x16 __attribute__((ext_vector_type(16)));

constexpr int T = 32768, DM = 2048, DFF = 5504, NINP = 3072, SEQ = 4096;
constexpr int NWAVES = 8, NTHREADS = 512, LDS_BYTES = 131072 + 16384, RL_OFF = 131072;
constexpr float EPS = 1e-6f;
constexpr int ZC_KV = 512, ZC_ROPE = 768, ZC_U = 832, ZC_V = 1856;
constexpr int GO_PITCH = 4096;

constexpr size_t O_W13A = 0, O_W13B = 45088768, O_W2A = 90177536, O_W2B = 112721920, O_WIN = 135266304, O_WUQ = 147849216, O_WUKV = 149422080, O_WOUT = 150470656, O_WGATE = 158859264, O_WPLE = 167247872;
constexpr size_t O_XN = 168296448, O_ER = O_XN + 134217728, O_PB = O_ER + 134217728, O_BIG = O_PB + 16777216;
constexpr size_t O_ACT = O_BIG, O_Z = O_BIG, O_QR = O_BIG + 201326592, O_KVR = O_QR + 100663296, O_KB = O_KVR + 134217728, O_VT = O_KB + 100663296, O_END = O_VT + 67108864;
constexpr size_t O_CQN = O_KB, O_CKVN = O_VT, O_AO = O_KVR, O_GO = O_KVR + 67108864;
constexpr size_t SLAB = 75497472, S_ACT = 0, S_Z = 0, S_MIX = 0, S_QR = 25165824, S_KVR = S_QR + 12582912, S_AO = S_KVR, S_GO = S_KVR + 8388608, S_KB = S_KVR + 16777216, S_VT = S_KB + 12582912, S_CQN = S_KB, S_CKVN = S_VT, S_HBALT = S_KB;
constexpr size_t BB_ACT = (size_t)SEQ * DFF * 2, BB_Z = (size_t)SEQ * NINP * 2, BB_MIX = (size_t)SEQ * DM * 2, BB_QR = (size_t)SEQ * 1536 * 2, BB_KVR = (size_t)SEQ * 2048 * 2, BB_AO = (size_t)SEQ * 1024 * 2, BB_KB = (size_t)8 * SEQ * 192 * 2, BB_VT = (size_t)8 * 128 * SEQ * 2, BB_CQN = (size_t)SEQ * 512 * 2, BB_CKVN = (size_t)SEQ * 256 * 2, BB_HB = (size_t)SEQ * DM * 2;
static_assert(S_VT + BB_VT == SLAB && S_HBALT + BB_HB <= SLAB && BB_ACT <= SLAB && 8 * SLAB == 603979776, "slab map");
constexpr size_t O_HB = O_XN  , O_HBALT = O_KB  , O_MIX = O_BIG  ;
constexpr size_t O_SS = O_END  , O_SSE = O_SS + 8 * 262144  , O_SSQ = O_SSE + 2 * 262144  , O_BAR = O_SSQ + 4 * 262144  , O_END2 = O_BAR + 4096;

struct Args { const float* in[29]; float* out; unsigned char* ws; };
typedef const __attribute__((address_space(4))) Args* ArgsP;
DI ArgsP args_ptr() { ArgsP p = (ArgsP)__builtin_amdgcn_kernarg_segment_ptr(); asm volatile("" : "+s"(p)); return p; }
DI int fresh_tid() { int t = threadIdx.x; asm volatile("" : "+v"(t)); return t; }
struct Grp { int grp, mi, GM, r0, rstride, rend; };
DI Grp make_grp(int G) { Grp g; g.grp = blockIdx.x & 7; g.mi = blockIdx.x >> 3; g.GM = G >> 3; g.r0 = g.grp * SEQ + g.mi * NWAVES; g.rstride = g.GM * NWAVES; g.rend = (g.grp + 1) * SEQ; return g; }

DI float wave_sum(float v) {
#pragma unroll
    for (int o = 1; o < 64; o <<= 1) v += __shfl_xor(v, o);
    return v;
}
DI float blo(unsigned u) { return __uint_as_float(u << 16); }
DI float bhi(unsigned u) { return __uint_as_float(u & 0xffff0000u); }
DI float gelu_tanh(float x) { const float u = x * (1.f + 0.044715f * x * x); return x * __builtin_amdgcn_rcpf(1.f + __builtin_amdgcn_exp2f(-2.3022081981f * u)); }
DI float dot4(f32x4 v) { return (v[0] * v[0] + v[1] * v[1]) + (v[2] * v[2] + v[3] * v[3]); }

struct CvtD { const float* src; const float* gain; bf16_t* dst; int N, K; };
DI CvtD cvt_mk(const float* W, int K, int N, bf16_t* WT, int mode, int item, const float* gain) {
    const int nblk = N >> 5, kb = item / nblk, nb = item - kb * nblk, k0 = kb * 64, n0 = nb * 32;
    int d0 = n0; if (mode) d0 = (n0 >> 7) * 256 + (n0 & 127) + (mode == 2 ? 128 : 0);
    CvtD d; d.src = W + (size_t)k0 * N + n0; d.gain = gain ? gain + k0 : nullptr; d.dst = WT + (size_t)d0 * K + k0; d.N = N; d.K = K; return d;
}
DI CvtD cvt_desc(ArgsP A, int layer, int it) {
    unsigned char* ws = A->ws;
    constexpr int I_FF = 32 * 172, I_2 = 86 * 64, I_IN = 32 * 90, I_UQ = 8 * 48, I_UKV = 4 * 64, I_SQ = 32 * 64;
    const size_t LFF = (size_t)layer * DM * DFF, LSQ = (size_t)layer * DM * DM;
    int r = it;
    if (r < I_FF) return cvt_mk(A->in[4] + LFF, DM, DFF, (bf16_t*)(ws + O_W13A), 1, r, A->in[3] + layer * DM); r -= I_FF;
    if (r < I_FF) return cvt_mk(A->in[5] + LFF, DM, DFF, (bf16_t*)(ws + O_W13A), 2, r, A->in[3] + layer * DM); r -= I_FF;
    if (r < I_2)  return cvt_mk(A->in[6] + LFF, DFF, DM, (bf16_t*)(ws + O_W2A), 0, r, nullptr); r -= I_2;
    if (r < I_FF) return cvt_mk(A->in[22] + LFF, DM, DFF, (bf16_t*)(ws + O_W13B), 1, r, A->in[21] + layer * DM); r -= I_FF;
    if (r < I_FF) return cvt_mk(A->in[23] + LFF, DM, DFF, (bf16_t*)(ws + O_W13B), 2, r, A->in[21] + layer * DM); r -= I_FF;
    if (r < I_2)  return cvt_mk(A->in[24] + LFF, DFF, DM, (bf16_t*)(ws + O_W2B), 0, r, nullptr); r -= I_2;
    if (r < I_IN) return cvt_mk(A->in[8] + (size_t)layer * DM * 2880, DM, 2880, (bf16_t*)(ws + O_WIN), 0, r, A->in[7] + layer * DM); r -= I_IN;
    if (r < I_UQ) return cvt_mk(A->in[10] + (size_t)layer * 512 * 1536, 512, 1536, (bf16_t*)(ws + O_WUQ), 0, r, A->in[9] + layer * 512); r -= I_UQ;
    if (r < I_UKV) return cvt_mk(A->in[12] + (size_t)layer * 256 * 2048, 256, 2048, (bf16_t*)(ws + O_WUKV), 0, r, A->in[11] + layer * 256); r -= I_UKV;
    if (r < I_SQ) return cvt_mk(A->in[20] + LSQ, DM, DM, (bf16_t*)(ws + O_WOUT), 0, r, nullptr); r -= I_SQ;
    if (r < I_SQ) return cvt_mk(A->in[26] + LSQ, DM, DM, (bf16_t*)(ws + O_WGATE), 0, r, A->in[25] + layer * DM); r -= I_SQ;
    return cvt_mk(A->in[27] + (size_t)layer * 256 * 2048, 256, 2048, (bf16_t*)(ws + O_WPLE), 0, r, nullptr);
}
DI void cvt_load(const CvtD& d, float (&v)[32], int lane) {
    const float* src = d.src + (size_t)(lane >> 5) * d.N + (lane & 31);
#pragma unroll
    for (int i = 0; i < 32; ++i) v[i] = __builtin_nontemporal_load(src + (size_t)(2 * i) * d.N);
}
DI void cvt_store(const CvtD& d, const float (&v)[32], LAS float* scr, int lane) {
#pragma unroll
    for (int i = 0; i < 32; ++i) scr[(2 * i + (lane >> 5)) * 33 + (lane & 31)] = v[i];
    LDS_WAIT();
    const int c = lane & 7;
    f32x4 g0 = {1.f, 1.f, 1.f, 1.f}, g1 = g0;
    if (d.gain) { g0 = *(const f32x4*)(d.gain + 8 * c); g1 = *(const f32x4*)(d.gain + 8 * c + 4); }
#pragma unroll
    for (int j = 0; j < 4; ++j) { const int n = (lane >> 3) + 8 * j; const LAS float* s = scr + (8 * c) * 33 + n;
        u32x4 o; o.x = pk2(s[0] * g0[0], s[33] * g0[1]); o.y = pk2(s[66] * g0[2], s[99] * g0[3]); o.z = pk2(s[132] * g1[0], s[165] * g1[1]); o.w = pk2(s[198] * g1[2], s[231] * g1[3]);
        *(u32x4*)(d.dst + (size_t)n * d.K + 8 * c) = o; }
    LDS_WAIT();
}
DI void phase_convert(ArgsP A, int layer, LAS unsigned char* lds, int tid, int wave, int lane, int G) {
    LAS float* scr = (LAS float*)(lds + wave * 8448);
    unsigned char* ws = A->ws;
    const int gw = blockIdx.x * NWAVES + wave, NGW = G * NWAVES;
    constexpr int NITEMS = 4 * (32 * 172) + 2 * (86 * 64) + 32 * 90 + 8 * 48 + 4 * 64 + 2 * (32 * 64) + 4 * 64;
    { CvtD nd; float nv[32];
      if (gw < NITEMS) { nd = cvt_desc(A, layer, gw); cvt_load(nd, nv, lane); }
      for (int it = gw; it < NITEMS; it += NGW) {
          const CvtD cd = nd; float cv[32];
#pragma unroll
          for (int i = 0; i < 32; ++i) cv[i] = nv[i];
          if (it + NGW < NITEMS) { nd = cvt_desc(A, layer, it + NGW); cvt_load(nd, nv, lane); }
          cvt_store(cd, cv, scr, lane);
      } }
    const int gt = blockIdx.x * NTHREADS + tid, NGT = G * NTHREADS;
    { u32x4* z = (u32x4*)(ws + O_WIN + (size_t)2880 * DM * 2); const u32x4 zero = {0u, 0u, 0u, 0u};
      for (int i = gt; i < 192 * DM / 8; i += NGT) z[i] = zero; }
    { const f32x4* p = (const f32x4*)(A->in[1] + (size_t)layer * T * 256); u32x4* o = (u32x4*)(ws + O_PB);
      for (int i = gt; i < T * 256 / 8; i += NGT) { const f32x4 a = __builtin_nontemporal_load(p + 2 * i), b = __builtin_nontemporal_load(p + 2 * i + 1); u32x4 w; w.x = pk2(a[0], a[1]); w.y = pk2(a[2], a[3]); w.z = pk2(b[0], b[1]); w.w = pk2(b[2], b[3]); o[i] = w; } }
}

DI void phase_x0(const float* x, bf16_t* HB, ssq_t* SS, int tid, int wave, int lane, const Grp gr) {
    const int gw = gr.r0 + wave, NGW = gr.rstride, REND = gr.rend;
    for (int i = gr.mi * NTHREADS + tid; i < 13 * SEQ; i += gr.GM * NTHREADS) SS[(size_t)(1 + (i >> 12)) * T + gr.grp * SEQ + (i & 4095)] = 0ull;
    for (int row0 = gw; row0 < REND; row0 += 2 * NGW) {
        f32x4 v[2][8];
#pragma unroll
        for (int r = 0; r < 2; ++r) { const int row = row0 + r * NGW; if (row < REND) { const f32x4* xr = (const f32x4*)(x + (size_t)row * DM) + lane;
#pragma unroll
            for (int j = 0; j < 8; ++j) v[r][j] = __builtin_nontemporal_load(xr + 64 * j); } }
#pragma unroll
        for (int r = 0; r < 2; ++r) { const int row = row0 + r * NGW; if (row < REND) { float s = 0.f;
#pragma unroll
            for (int j = 0; j < 8; ++j) s += dot4(v[r][j]);
            s = wave_sum(s); if (lane == 0) SS[row] = pg8::ssq_from_f(s);
            u32x2* o = (u32x2*)(HB + (size_t)row * DM) + lane;
#pragma unroll
            for (int j = 0; j < 8; ++j) { u32x2 w; w.x = pk2(v[r][j][0], v[r][j][1]); w.y = pk2(v[r][j][2], v[r][j][3]); o[64 * j] = w; } } }
    }
}
DI void phase_mixnorm(const bf16_t* AO, const bf16_t* GO, const float* ga, const float* gg, bf16_t* XN, int wave, int lane, const Grp gr) {
    const int gw = gr.r0 + wave, NGW = gr.rstride, REND = gr.rend;
    for (int row0 = gw; row0 < REND; row0 += 4 * NGW) {
        u32x4 v[4][2][2];
#pragma unroll
        for (int r = 0; r < 4; ++r) { const int row = row0 + r * NGW; if (row < REND) {
#pragma unroll
            for (int part = 0; part < 2; ++part) { const bf16_t* src = part ? GO + (size_t)row * GO_PITCH : AO + (size_t)row * 1024;
#pragma unroll
                for (int j = 0; j < 2; ++j) v[r][part][j] = *(const u32x4*)(src + (lane + 64 * j) * 8); } } }
#pragma unroll
        for (int r = 0; r < 4; ++r) { const int row = row0 + r * NGW; if (row < REND) {
#pragma unroll
            for (int part = 0; part < 2; ++part) { const float* gn = part ? gg : ga; float s = 0.f;
#pragma unroll
                for (int j = 0; j < 2; ++j)
#pragma unroll
                    for (int k = 0; k < 4; ++k) { const float a = blo(v[r][part][j][k]), b = bhi(v[r][part][j][k]); s += a * a + b * b; }
                const float rstd = rsqrtf(wave_sum(s) * (1.f / 1024.f) + EPS);
#pragma unroll
                for (int j = 0; j < 2; ++j) { const int c0 = (lane + 64 * j) * 8; const f32x4 g0 = *(const f32x4*)(gn + c0), g1 = *(const f32x4*)(gn + c0 + 4); const u32x4 x = v[r][part][j]; u32x4 w;
                    w.x = pk2(blo(x.x) * rstd * g0[0], bhi(x.x) * rstd * g0[1]); w.y = pk2(blo(x.y) * rstd * g0[2], bhi(x.y) * rstd * g0[3]);
                    w.z = pk2(blo(x.z) * rstd * g1[0], bhi(x.z) * rstd * g1[1]); w.w = pk2(blo(x.w) * rstd * g1[2], bhi(x.w) * rstd * g1[3]);
                    *(u32x4*)(XN + (size_t)row * DM + part * 1024 + c0) = w; } } } }
    }
}

DI void norm_rope_store(const LAS float* buf, const LAS float* cs, const float* gain, float scale, bf16_t* dst, size_t hstride, int lane) {
    const int hd8 = lane >> 3, sub = lane & 7;
    const LAS f32x4* p = (const LAS f32x4*)(buf + hd8 * 192 + sub * 24);
    float ss = 0.f;
#pragma unroll
    for (int i = 0; i < 6; ++i) ss += dot4(p[i]);
    ss += __shfl_xor(ss, 1); ss += __shfl_xor(ss, 2); ss += __shfl_xor(ss, 4);
    const float rstd_own = rsqrtf(ss * (1.f / 192.f) + EPS) * scale;
#pragma unroll
    for (int j = 0; j < 3; ++j) {
        const int e0 = (lane + 64 * j) * 8, hd = e0 / 192, d0 = e0 - hd * 192;
        const float rs = __shfl(rstd_own, hd * 8);
        const f32x4 x0 = *(const LAS f32x4*)(buf + e0), x1 = *(const LAS f32x4*)(buf + e0 + 4), g0 = *(const f32x4*)(gain + d0), g1 = *(const f32x4*)(gain + d0 + 4);
        f32x4 v0 = x0 * g0, v1 = x1 * g1;
        if (d0 >= 128) {
            const bool lo = d0 < 160; const int po = lo ? 32 : -32, ci = lo ? d0 - 128 : d0 - 160;
            const f32x4 y0 = *(const LAS f32x4*)(buf + e0 + po), y1 = *(const LAS f32x4*)(buf + e0 + po + 4), h0 = *(const f32x4*)(gain + d0 + po), h1 = *(const f32x4*)(gain + d0 + po + 4);
            const f32x4 c0 = *(const LAS f32x4*)(cs + ci), c1 = *(const LAS f32x4*)(cs + ci + 4), s0 = *(const LAS f32x4*)(cs + 32 + ci), s1 = *(const LAS f32x4*)(cs + 32 + ci + 4);
            const f32x4 p0 = y0 * h0, p1 = y1 * h1;
            if (lo) { v0 = v0 * c0 - p0 * s0; v1 = v1 * c1 - p1 * s1; } else { v0 = v0 * c0 + p0 * s0; v1 = v1 * c1 + p1 * s1; }
        }
        v0 = v0 * rs; v1 = v1 * rs;
        u32x4 w; w.x = pk2(v0[0], v0[1]); w.y = pk2(v0[2], v0[3]); w.z = pk2(v1[0], v1[1]); w.w = pk2(v1[2], v1[3]);
        *(u32x4*)(dst + (size_t)hd * hstride + d0) = w;
    }
}
DI void store8f(LAS float* d, u32x4 a) {
    *(LAS f32x4*)d = (f32x4){blo(a.x), bhi(a.x), blo(a.y), bhi(a.y)}; *(LAS f32x4*)(d + 4) = (f32x4){blo(a.z), bhi(a.z), blo(a.w), bhi(a.w)};
}
DI void phase_prep_b(bf16_t* QR, const bf16_t* KVR, const bf16_t* Z, const int* positions, const float* qn, const float* kn, bf16_t* KB, bf16_t* VT, LAS unsigned char* lds, int tid, int wave, int lane, const Grp gr, const bool do_q = true) {
    LAS float* buf = (LAS float*)(lds + wave * 12544); LAS float* bufk = buf + 1536; LAS float* cs = buf + 3072;
    const int gw = gr.r0 + wave, NGW = gr.rstride, REND = gr.rend;
    const float qscale = 0.07216878364870322f * 1.4426950408889634f;
    double invf = 1.0; { double base = 0.7498942093324558;
#pragma unroll
        for (int bit = 0; bit < 5; ++bit) { if ((lane >> bit) & 1) invf *= base; base *= base; } }
    const float invf32 = (float)invf;
    u32x4 nq[3], nk[3]; int npos = 0;
#define PB_LOAD(tk) do { const bf16_t* qrow_ = QR + (size_t)(tk) * 1536; npos = positions[tk]; \
        _Pragma("unroll") for (int j = 0; j < 3; ++j) { nq[j] = *(const u32x4*)(qrow_ + (lane + 64 * j) * 8); \
            const int c = lane + 64 * j, hd = c / 24, cc = c - hd * 24; \
            const bf16_t* src = cc < 16 ? KVR + (size_t)(tk) * 2048 + hd * 256 + cc * 8 : Z + (size_t)(tk) * NINP + ZC_ROPE + (cc - 16) * 8; nk[j] = *(const u32x4*)src; } } while (0)
    if (gw < REND) PB_LOAD(gw);
    for (int tok = gw; tok < REND; tok += NGW) {
        const int b = tok >> 12, s = tok & 4095;
        u32x4 cq[3], ck[3]; const int pos = npos;
#pragma unroll
        for (int j = 0; j < 3; ++j) { cq[j] = nq[j]; ck[j] = nk[j]; }
        if (tok + NGW < REND) PB_LOAD(tok + NGW);
        if (lane < 32) { const float ang = (float)pos * invf32; double rev = (double)ang * 0.15915494309189535; rev -= __builtin_rint(rev); const float f = (float)rev;
            cs[lane] = __builtin_amdgcn_cosf(f); cs[32 + lane] = __builtin_amdgcn_sinf(f); }
        bf16_t* qrow = QR + (size_t)tok * 1536;
#pragma unroll
        for (int j = 0; j < 3; ++j) { store8f(buf + (lane + 64 * j) * 8, cq[j]); store8f(bufk + (lane + 64 * j) * 8, ck[j]); }
        LDS_WAIT();
        if (do_q) norm_rope_store(buf, cs, qn, qscale, qrow, 192, lane);
        norm_rope_store(bufk, cs, kn, 1.f, KB + ((size_t)(b * 8) * SEQ + s) * 192, (size_t)SEQ * 192, lane);
        LDS_WAIT();
    }
#undef PB_LOAD
}

#define MFMA32(a, b, c) __builtin_amdgcn_mfma_f32_32x32x16_bf16((a), (b), (c), 0, 0, 0)
typedef short s16x4 __attribute__((ext_vector_type(4)));
DI bf16x8 trv_read(const LAS unsigned char* p) {
    const s16x4 lo = __builtin_amdgcn_ds_read_tr16_b64_v4i16((LAS s16x4*)p), hi = __builtin_amdgcn_ds_read_tr16_b64_v4i16((LAS s16x4*)(p + 8 * 320));
    return (bf16x8){lo[0], lo[1], lo[2], lo[3], hi[0], hi[1], hi[2], hi[3]};
}
#define TRV(p) trv_read((const LAS unsigned char*)(p))
constexpr int KROW_B = 400, VROW_B = 320, KT_B = 64 * KROW_B, VT_B = 64 * VROW_B, STG_B = KT_B + VT_B;
DI void attn_block(const bf16_t* Q, const bf16_t* Kb, const bf16_t* Vt, bf16_t* AO, LAS unsigned char* lds, int bh, int qb, int tid, int wave, int lane) {
    const int b = bh >> 3, h = bh & 7, l31 = lane & 31, hh = lane >> 5;
    const int q0 = qb * 256, qw = q0 + wave * 32, nkt = 4 * (qb + 1);
    const bf16_t* Kbase = Kb + (size_t)bh * SEQ * 192; const bf16_t* Vbase = Vt + (size_t)b * SEQ * 2048 + h * 256 + 128;
    bf16x8 qf[12];
    { const bf16_t* qp = Q + (size_t)(b * SEQ + qw + l31) * 1536 + h * 192 + 8 * hh;
#pragma unroll
      for (int s = 0; s < 12; ++s) qf[s] = *(const bf16x8*)(qp + 16 * s); }
    f32x16 o[4];
#pragma unroll
    for (int d = 0; d < 4; ++d)
#pragma unroll
        for (int i = 0; i < 16; ++i) o[d][i] = 0.f;
    float m = -1e30f, l = 0.f;
    const int kgo = (tid >> 3) * 192 + (tid & 7) * 8, klo = (tid >> 3) * KROW_B + (tid & 7) * 16;
    const int vgo = (tid >> 4) * 2048 + (tid & 15) * 8, vlo = KT_B + (tid >> 4) * VROW_B + (tid & 15) * 16;
    u32x4 kr[3], vr[2];
#define ATT_GLOAD(kt) do { _Pragma("unroll") for (int i = 0; i < 3; ++i) kr[i] = *(const u32x4*)(Kbase + (size_t)(kt) * 64 * 192 + kgo + 64 * i); \
        _Pragma("unroll") for (int i = 0; i < 2; ++i) vr[i] = *(const u32x4*)(Vbase + (size_t)(kt) * 64 * 2048 + vgo + 32 * i * 2048); } while (0)
#define ATT_LSTORE(st) do { _Pragma("unroll") for (int i = 0; i < 3; ++i) *(LAS u32x4*)(lds + (st) * STG_B + klo + 128 * i) = kr[i]; \
        _Pragma("unroll") for (int i = 0; i < 2; ++i) *(LAS u32x4*)(lds + (st) * STG_B + vlo + 32 * i * VROW_B) = vr[i]; } while (0)
    ATT_GLOAD(0); ATT_LSTORE(0);
    __syncthreads();
    const int koff = l31 * KROW_B + 16 * hh, voff = KT_B + (4 * hh + ((lane >> 2) & 3)) * VROW_B + (16 * ((lane >> 4) & 1) + 4 * (lane & 3)) * 2;
    for (int kt = 0; kt < nkt; ++kt) {
        const int st = kt & 1, k0 = kt * 64;
        const bool more = kt + 1 < nkt;
        if (more) ATT_GLOAD(kt + 1);
        if (k0 <= qw + 31) {
            const LAS unsigned char* sb = lds + st * STG_B;
            f32x16 sa[2];
#pragma unroll
            for (int kb = 0; kb < 2; ++kb)
#pragma unroll
                for (int i = 0; i < 16; ++i) sa[kb][i] = 0.f;
            {
                bf16x8 fr[2][4];
#pragma unroll
                for (int j = 0; j < 4; ++j) fr[0][j] = *(const LAS bf16x8*)(sb + koff + 32 * j);
                __builtin_amdgcn_sched_barrier(0);
#pragma unroll
                for (int g = 0; g < 6; ++g) {
                    if (g < 5) {
#pragma unroll
                        for (int j = 0; j < 4; ++j) { const int s = (g + 1) * 4 + j; fr[(g + 1) & 1][j] = *(const LAS bf16x8*)(sb + koff + (s / 12) * 32 * KROW_B + 32 * (s % 12)); }
                    }
#pragma unroll
                    for (int j = 0; j < 4; ++j) { const int s = g * 4 + j; sa[s / 12] = MFMA32(fr[g & 1][j], qf[s % 12], sa[s / 12]); }
                    __builtin_amdgcn_sched_barrier(0);
                }
            }
            if (k0 + 63 > qw) {
                const int qg = qw + l31;
#pragma unroll
                for (int kb = 0; kb < 2; ++kb)
#pragma unroll
                    for (int i = 0; i < 16; ++i) { const int key = k0 + kb * 32 + (i & 3) + 8 * (i >> 2) + 4 * hh; if (key > qg) sa[kb][i] = -1e30f; }
            }
            float mx = -1e30f;
#pragma unroll
            for (int kb = 0; kb < 2; ++kb)
#pragma unroll
                for (int i = 0; i < 16; ++i) mx = fmaxf(mx, sa[kb][i]);
            mx = fmaxf(mx, __shfl_xor(mx, 32));
            if (__any(mx - m > 6.0f)) {
                const float mnew = fmaxf(m, mx), alpha = __builtin_amdgcn_exp2f(m - mnew); m = mnew; l *= alpha;
#pragma unroll
                for (int d = 0; d < 4; ++d)
#pragma unroll
                    for (int i = 0; i < 16; ++i) o[d][i] *= alpha;
            }
            float ls = 0.f;
#pragma unroll
            for (int kb = 0; kb < 2; ++kb)
#pragma unroll
                for (int i = 0; i < 16; ++i) { const float p = __builtin_amdgcn_exp2f(sa[kb][i] - m); sa[kb][i] = p; ls += p; }
            l += ls;
            bf16x8 pf[4];
#pragma unroll
            for (int kb = 0; kb < 2; ++kb)
#pragma unroll
                for (int s = 0; s < 2; ++s) { u32x4 w; w.x = pk2(sa[kb][8 * s], sa[kb][8 * s + 1]); w.y = pk2(sa[kb][8 * s + 2], sa[kb][8 * s + 3]);
                    w.z = pk2(sa[kb][8 * s + 4], sa[kb][8 * s + 5]); w.w = pk2(sa[kb][8 * s + 6], sa[kb][8 * s + 7]); pf[kb * 2 + s] = __builtin_bit_cast(bf16x8, w); }
            {
                bf16x8 fv[2][4];
#pragma unroll
                for (int j = 0; j < 4; ++j) fv[0][j] = TRV(sb + voff + j * 16 * VROW_B);
                __builtin_amdgcn_sched_barrier(0);
#pragma unroll
                for (int d = 0; d < 4; ++d) {
                    if (d < 3) {
#pragma unroll
                        for (int j = 0; j < 4; ++j) fv[(d + 1) & 1][j] = TRV(sb + voff + (d + 1) * 64 + j * 16 * VROW_B);
                    }
#pragma unroll
                    for (int j = 0; j < 4; ++j) o[d] = MFMA32(fv[d & 1][j], pf[j], o[d]);
                    __builtin_amdgcn_sched_barrier(0);
                }
            }
        }
        if (more) ATT_LSTORE(st ^ 1);
        __syncthreads();
    }
#undef ATT_GLOAD
#undef ATT_LSTORE
    const float inv = __builtin_amdgcn_rcpf(l + __shfl_xor(l, 32));
    bf16_t* orow = AO + (size_t)(b * SEQ + qw + l31) * 1024 + h * 128 + 4 * hh;
#pragma unroll
    for (int d = 0; d < 4; ++d)
#pragma unroll
        for (int g4 = 0; g4 < 4; ++g4) { u32x2 w; w.x = pk2(o[d][4 * g4] * inv, o[d][4 * g4 + 1] * inv); w.y = pk2(o[d][4 * g4 + 2] * inv, o[d][4 * g4 + 3] * inv);
            *(u32x2*)(orow + d * 32 + 8 * g4) = w; }
}
DI void phase_attn(const bf16_t* Q, const bf16_t* Kb, const bf16_t* Vt, bf16_t* AO, LAS unsigned char* lds, int tid, int wave, int lane, const Grp gr) {
    for (int k = gr.mi; k < 64; k += gr.GM) {
        const int pp = gr.grp * 64 + k, bh = pp >> 3, j = pp & 7;
        attn_block(Q, Kb, Vt, AO, lds, bh, 15 - j, tid, wave, lane);
        attn_block(Q, Kb, Vt, AO, lds, bh, j, tid, wave, lane);
    }
}

DI void phase_gmlp(const bf16_t* Z, const float* gv, const float* Ws, const float* bs, bf16_t* GO, LAS unsigned char* lds, int tid, int wave, int lane, const Grp gr) {
    LAS bf16_t* vct = (LAS bf16_t*)lds;
    LAS float* rs = (LAS float*)(lds + 128 * 272);
    const int l31 = lane & 31, hh = lane >> 5, tb = wave >> 1, dh = wave & 1, nks = 2 * (tb + 1);
    for (int it = gr.mi; it < 32; it += gr.GM) {
        const int t0 = (gr.grp * 32 + it) * 128;
        __syncthreads();
#pragma unroll
        for (int rb = 0; rb < 2; ++rb) { u32x4 vv[8][2];
#pragma unroll
            for (int r = 0; r < 8; ++r) { const bf16_t* zr = Z + (size_t)(t0 + wave * 16 + rb * 8 + r) * NINP + ZC_V;
#pragma unroll
                for (int j = 0; j < 2; ++j) vv[r][j] = *(const u32x4*)(zr + (lane + 64 * j) * 8); }
#pragma unroll
            for (int r = 0; r < 8; ++r) { float s = 0.f;
#pragma unroll
                for (int j = 0; j < 2; ++j)
#pragma unroll
                    for (int k = 0; k < 4; ++k) { const float x = gelu_tanh(blo(vv[r][j][k])), y = gelu_tanh(bhi(vv[r][j][k])); s += x * x + y * y; }
                s = wave_sum(s); if (lane == 0) rs[wave * 16 + rb * 8 + r] = rsqrtf(s * (1.f / 1024.f) + EPS); } }
        __syncthreads();
        const int vs_ = tid >> 2, vdq = tid & 3, t = tb * 32 + l31;
        const bf16_t* zv = Z + (size_t)(t0 + vs_) * NINP + ZC_V + vdq * 32;
        const float* wrow = Ws + (size_t)t * 128 + 8 * hh;
        const bf16_t* ur = Z + (size_t)(t0 + t) * NINP + ZC_U + dh * 64 + 4 * hh;
        u32x4 va[4]; f32x4 wa[8][2]; u32x2 uv[2][4]; float bsv;
#define GM_LDV(g_) do { _Pragma("unroll") for (int c = 0; c < 4; ++c) va[c] = *(const u32x4*)(zv + (g_) * 128 + 8 * c); } while (0)
#define GM_LDW(g_) do { _Pragma("unroll") for (int ks = 0; ks < 8; ++ks) if (ks < nks) { wa[ks][0] = *(const f32x4*)(wrow + (size_t)(g_) * 16384 + 16 * ks); wa[ks][1] = *(const f32x4*)(wrow + (size_t)(g_) * 16384 + 16 * ks + 4); } } while (0)
#define GM_LDU(g_) do { bsv = bs[(g_) * 128 + t]; _Pragma("unroll") for (int db = 0; db < 2; ++db) _Pragma("unroll") for (int g4 = 0; g4 < 4; ++g4) uv[db][g4] = *(const u32x2*)(ur + (g_) * 128 + db * 32 + 8 * g4); } while (0)
        GM_LDV(0); GM_LDW(0); GM_LDU(0);
        for (int g = 0; g < 8; ++g) {
            { const float r = rs[vs_]; const float* gp = gv + g * 128 + vdq * 32;
#pragma unroll
              for (int c = 0; c < 4; ++c) { const u32x4 a = va[c]; const f32x4 g0 = *(const f32x4*)(gp + 8 * c), g1 = *(const f32x4*)(gp + 8 * c + 4);
                  LAS bf16_t* dcol = vct + (vdq * 32 + 8 * c) * 136 + vs_;
                  dcol[0 * 136] = (bf16_t)(pk2(gelu_tanh(blo(a.x)) * r * g0[0], 0.f) & 0xffffu); dcol[1 * 136] = (bf16_t)(pk2(gelu_tanh(bhi(a.x)) * r * g0[1], 0.f) & 0xffffu);
                  dcol[2 * 136] = (bf16_t)(pk2(gelu_tanh(blo(a.y)) * r * g0[2], 0.f) & 0xffffu); dcol[3 * 136] = (bf16_t)(pk2(gelu_tanh(bhi(a.y)) * r * g0[3], 0.f) & 0xffffu);
                  dcol[4 * 136] = (bf16_t)(pk2(gelu_tanh(blo(a.z)) * r * g1[0], 0.f) & 0xffffu); dcol[5 * 136] = (bf16_t)(pk2(gelu_tanh(bhi(a.z)) * r * g1[1], 0.f) & 0xffffu);
                  dcol[6 * 136] = (bf16_t)(pk2(gelu_tanh(blo(a.w)) * r * g1[2], 0.f) & 0xffffu); dcol[7 * 136] = (bf16_t)(pk2(gelu_tanh(bhi(a.w)) * r * g1[3], 0.f) & 0xffffu); } }
            if (g < 7) GM_LDV(g + 1);
            bf16x8 wf[8];
#pragma unroll
            for (int ks = 0; ks < 8; ++ks) { if (ks < nks) { const f32x4 a = wa[ks][0], c = wa[ks][1]; const int s0 = 16 * ks + 8 * hh; float v[8];
#pragma unroll
                    for (int i = 0; i < 4; ++i) { v[i] = (s0 + i <= t) ? a[i] : 0.f; v[4 + i] = (s0 + 4 + i <= t) ? c[i] : 0.f; }
                    u32x4 w; w.x = pk2(v[0], v[1]); w.y = pk2(v[2], v[3]); w.z = pk2(v[4], v[5]); w.w = pk2(v[6], v[7]); wf[ks] = __builtin_bit_cast(bf16x8, w); }
                else wf[ks] = (bf16x8){0, 0, 0, 0, 0, 0, 0, 0}; }
            if (g < 7) GM_LDW(g + 1);
            __syncthreads();
            f32x16 acc[2];
#pragma unroll
            for (int db = 0; db < 2; ++db) {
#pragma unroll
                for (int i = 0; i < 16; ++i) acc[db][i] = 0.f;
#pragma unroll
                for (int ks = 0; ks < 8; ++ks) if (ks < nks) { const bf16x8 a = *(const LAS bf16x8*)((const LAS unsigned char*)vct + (dh * 64 + db * 32 + l31) * 272 + 32 * ks + 16 * hh); acc[db] = MFMA32(a, wf[ks], acc[db]); }
            }
            bf16_t* orow = GO + (size_t)(t0 + t) * GO_PITCH + g * 128 + dh * 64 + 4 * hh;
#pragma unroll
            for (int db = 0; db < 2; ++db)
#pragma unroll
                for (int g4 = 0; g4 < 4; ++g4) { const u32x2 u = uv[db][g4]; u32x2 w;
                    w.x = pk2(gelu_tanh(blo(u.x)) * (acc[db][4 * g4] + bsv), gelu_tanh(bhi(u.x)) * (acc[db][4 * g4 + 1] + bsv));
                    w.y = pk2(gelu_tanh(blo(u.y)) * (acc[db][4 * g4 + 2] + bsv), gelu_tanh(bhi(u.y)) * (acc[db][4 * g4 + 3] + bsv));
                    *(u32x2*)(orow + db * 32 + 8 * g4) = w; }
            if (g < 7) GM_LDU(g + 1);
            __syncthreads();
        }
#undef GM_LDV
#undef GM_LDW
#undef GM_LDU
    }
}

struct PleOrder {
    int grp, mi, n;
    __device__ __forceinline__ bool next(int i, pg8::Unit& u) const { if (i >= n) return false; u.pm = grp * 16 + (mi - 16); u.pn = i; return true; }
    __device__ __forceinline__ void a_ready(const pg8::Unit&) const {}
    __device__ __forceinline__ void done(const pg8::Unit&) const {}
};
template <class Epi> DI void run_gemm_ple(LAS unsigned char* lds, const bf16_t* A, const bf16_t* Bt, const Epi& E, int tid) {
    pg8::Gemm g; g.A = A; g.Bt = Bt; g.M = T; g.N = DM; g.K = 256; g.lda = 256;
    PleOrder S; S.grp = blockIdx.x & 7; S.mi = blockIdx.x >> 3; { int n8 = S.mi < 16 ? 0 : 8; asm volatile("" : "+s"(n8)); S.n = n8; }
    pg8::gemm_phase<Epi, PleOrder, true, true>((PG8_LAS unsigned char*)lds, g, S, E, tid);
}
DI void fill_rstd_lds(LAS unsigned char* lds, const ssq_t* SS, int grp, int tid, float invn = 1.f / 2048.f) {
    LAS float* rl = (LAS float*)(lds + RL_OFF); const ssq_t* p = SS + (size_t)grp * SEQ;
    for (int i = tid; i < SEQ; i += NTHREADS) rl[i] = rsqrtf(pg8::ssq_to_f(p[i]) * invn + 1e-6f);
    __syncthreads();
}
template <class Epi> DI void run_gemm(LAS unsigned char* lds, const bf16_t* A, const bf16_t* Bt, int N, int K, const Epi& E, int G, int tid, int lda = 0) {
    pg8::Gemm g; g.A = A; g.Bt = Bt; g.M = T; g.N = N; g.K = K; g.lda = lda ? lda : K;
    pg8::StaticOrder S; S.init(T, N, G, (int)blockIdx.x);
    pg8::gemm_phase<Epi, pg8::StaticOrder, true, true>((PG8_LAS unsigned char*)lds, g, S, E, tid);
}

#define PH_BEGIN ArgsP A = args_ptr(); int w_ = wave_s; asm volatile("" : "+s"(w_)); int z_ = 0; asm volatile("" : "+v"(z_)); const int wave = w_, lane = (int)__builtin_amdgcn_mbcnt_hi(~0u, __builtin_amdgcn_mbcnt_lo(~0u, (unsigned)z_)), tid = wave * 64 + lane, G = gridDim.x; unsigned char* ws = A->ws; (void)ws; (void)G;

DI void grid_bar(unsigned* ctr, unsigned target, int tid) {
    asm volatile("s_waitcnt vmcnt(0)" ::: "memory");
    __syncthreads();
    if (tid == 0) {
        __builtin_amdgcn_fence(__ATOMIC_RELEASE, "agent");
        asm volatile("s_waitcnt vmcnt(0)" ::: "memory");
        __hip_atomic_fetch_add(ctr, 1u, __ATOMIC_RELAXED, __HIP_MEMORY_SCOPE_AGENT);
        while (__hip_atomic_load(ctr, __ATOMIC_RELAXED, __HIP_MEMORY_SCOPE_AGENT) < target) __builtin_amdgcn_s_sleep(1);
        __builtin_amdgcn_fence(__ATOMIC_ACQUIRE, "agent");
        asm volatile("s_waitcnt vmcnt(0)" ::: "memory");
    }
    __syncthreads();
}
#define PH_GRP const Grp gr = make_grp(G);
#define VP(S_, BB_) (ws + O_BIG + (size_t)gr.grp * (SLAB - (BB_)) + (S_))
#define GROUP_BAR(k) { PH_BEGIN PH_GRP grid_bar((unsigned*)(ws + O_BAR) + 64 * gr.grp, (unsigned)(k) * (unsigned)gr.GM, tid); }
#define CHIP_BAR(k) { PH_BEGIN grid_bar((unsigned*)(ws + O_BAR) + 64 * 8, (unsigned)(k) * (unsigned)G, tid); }
template <int layer> DI void layer_body(LAS unsigned char* lds, const int wave_s, int& bk) {
    {
        { PH_BEGIN PH_GRP fill_rstd_lds(lds, (const ssq_t*)(ws + O_SS) + (layer * 4 + 0) * T, gr.grp, tid); pg8::EpiSwiglu E; E.O = (bf16_t*)VP(S_ACT, BB_ACT); E.ldc = DFF; E.RL = (const PG8_LAS float*)(lds + RL_OFF);
          run_gemm(lds, layer == 0 ? (const bf16_t*)(ws + O_HB) : (const bf16_t*)VP(S_HBALT, BB_HB), (const bf16_t*)(ws + O_W13A), 2 * DFF, DM, E, G, tid); }
        { PH_BEGIN pg8::EpiBf16<false, true> E; E.O = (bf16_t*)(ws + O_ER); E.ldc = DM; E.RL = nullptr; E.SSout = (ssq_t*)(ws + O_SSE) + layer * T;
          run_gemm_ple(lds, (const bf16_t*)(ws + O_PB), (const bf16_t*)(ws + O_WPLE), E, tid); }
        GROUP_BAR(++bk)
        { PH_BEGIN PH_GRP pg8::EpiResid E; E.Rin = layer == 0 ? (const bf16_t*)(ws + O_HB) : (const bf16_t*)VP(S_HBALT, BB_HB); E.HB = (bf16_t*)(ws + O_HB); E.SSout = (ssq_t*)(ws + O_SS) + (layer * 4 + 1) * T; E.ldc = DM; E.scale = 0.5f;
          run_gemm(lds, (const bf16_t*)VP(S_ACT, BB_ACT), (const bf16_t*)(ws + O_W2A), DM, DFF, E, G, tid); }
        GROUP_BAR(++bk)
        { PH_BEGIN PH_GRP fill_rstd_lds(lds, (const ssq_t*)(ws + O_SS) + (layer * 4 + 1) * T, gr.grp, tid); pg8::EpiZ E; E.O = (bf16_t*)VP(S_Z, BB_Z); E.ldc = NINP; E.RL = (const PG8_LAS float*)(lds + RL_OFF); E.SSq = (ssq_t*)(ws + O_SSQ) + (layer * 2 + 0) * T; E.SSkv = (ssq_t*)(ws + O_SSQ) + (layer * 2 + 1) * T;
          run_gemm(lds, (const bf16_t*)(ws + O_HB), (const bf16_t*)(ws + O_WIN), NINP, DM, E, G, tid); }
        GROUP_BAR(++bk)
        { PH_BEGIN PH_GRP fill_rstd_lds(lds, (const ssq_t*)(ws + O_SSQ) + (layer * 2 + 0) * T, gr.grp, tid, 1.f / 512.f); pg8::EpiBf16<true, false> E; E.O = (bf16_t*)VP(S_QR, BB_QR); E.ldc = 1536; E.RL = (const PG8_LAS float*)(lds + RL_OFF); E.SSout = nullptr;
          run_gemm(lds, (const bf16_t*)VP(S_Z, BB_Z), (const bf16_t*)(ws + O_WUQ), 1536, 512, E, G, tid, NINP); }
        { PH_BEGIN PH_GRP fill_rstd_lds(lds, (const ssq_t*)(ws + O_SSQ) + (layer * 2 + 1) * T, gr.grp, tid, 1.f / 256.f); pg8::EpiBf16<true, false> E; E.O = (bf16_t*)VP(S_KVR, BB_KVR); E.ldc = 2048; E.RL = (const PG8_LAS float*)(lds + RL_OFF); E.SSout = nullptr;
          run_gemm(lds, (const bf16_t*)VP(S_Z, BB_Z) + ZC_KV, (const bf16_t*)(ws + O_WUKV), 2048, 256, E, G, tid, NINP); }
        GROUP_BAR(++bk)
        { PH_BEGIN PH_GRP phase_prep_b((bf16_t*)VP(S_QR, BB_QR), (const bf16_t*)VP(S_KVR, BB_KVR), (const bf16_t*)VP(S_Z, BB_Z), (const int*)A->in[2], A->in[13] + layer * 192, A->in[14] + layer * 192, (bf16_t*)VP(S_KB, BB_KB), (bf16_t*)VP(S_VT, BB_VT), lds, tid, wave, lane, gr); }
        GROUP_BAR(++bk)
        { PH_BEGIN PH_GRP phase_attn((const bf16_t*)VP(S_QR, BB_QR), (const bf16_t*)VP(S_KB, BB_KB), (const bf16_t*)VP(S_KVR, BB_KVR), (bf16_t*)VP(S_VT, BB_VT)  , lds, tid, wave, lane, gr); }
        { PH_BEGIN PH_GRP phase_gmlp((const bf16_t*)VP(S_Z, BB_Z), A->in[15] + layer * 1024, A->in[16] + (size_t)layer * 8 * 128 * 128, A->in[17] + layer * 1024, (bf16_t*)A->out, lds, tid, wave, lane, gr); }
        GROUP_BAR(++bk)
        { PH_BEGIN PH_GRP phase_mixnorm((const bf16_t*)VP(S_VT, BB_VT), (const bf16_t*)A->out, A->in[18] + layer * 1024, A->in[19] + layer * 1024, (bf16_t*)VP(S_MIX, BB_MIX), wave, lane, gr); }
        GROUP_BAR(++bk)
        { PH_BEGIN PH_GRP pg8::EpiResid E; E.Rin = (const bf16_t*)(ws + O_HB); E.HB = (bf16_t*)(ws + O_HB); E.SSout = (ssq_t*)(ws + O_SS) + (layer * 4 + 2) * T; E.ldc = DM; E.scale = 1.f;
          run_gemm(lds, (const bf16_t*)VP(S_MIX, BB_MIX), (const bf16_t*)(ws + O_WOUT), DM, DM, E, G, tid); }
        GROUP_BAR(++bk)
        { PH_BEGIN PH_GRP fill_rstd_lds(lds, (const ssq_t*)(ws + O_SS) + (layer * 4 + 2) * T, gr.grp, tid); pg8::EpiSwiglu E; E.O = (bf16_t*)VP(S_ACT, BB_ACT); E.ldc = DFF; E.RL = (const PG8_LAS float*)(lds + RL_OFF);
          run_gemm(lds, (const bf16_t*)(ws + O_HB), (const bf16_t*)(ws + O_W13B), 2 * DFF, DM, E, G, tid); }
        GROUP_BAR(++bk)
        { PH_BEGIN PH_GRP pg8::EpiResid E; E.Rin = (const bf16_t*)(ws + O_HB); E.HB = (bf16_t*)(ws + O_HB); E.SSout = (ssq_t*)(ws + O_SS) + (layer * 4 + 3) * T; E.ldc = DM; E.scale = 0.5f;
          run_gemm(lds, (const bf16_t*)VP(S_ACT, BB_ACT), (const bf16_t*)(ws + O_W2B), DM, DFF, E, G, tid); }
        GROUP_BAR(++bk)
        { PH_BEGIN PH_GRP pg8::EpiGate<layer == 1> E; E.Rin = (const bf16_t*)(ws + O_HB); E.Hout = A->out; E.E = (const bf16_t*)(ws + O_ER); E.SSin = (const ssq_t*)(ws + O_SS) + (layer * 4 + 3) * T; E.SSE = (const ssq_t*)(ws + O_SSE) + layer * T;
          E.pn = A->in[28] + layer * DM; E.HB = (bf16_t*)VP(S_HBALT, BB_HB); E.SSout = (ssq_t*)(ws + O_SS) + ((layer * 4 + 4) & 7) * T; E.ldc = DM;
          run_gemm(lds, (const bf16_t*)(ws + O_HB), (const bf16_t*)(ws + O_WGATE), DM, DM, E, G, tid); }
    }
}
__global__ void __launch_bounds__(NTHREADS, 2) hybrid_fwd(Args A_unused) {
    extern __shared__ __attribute__((aligned(16))) unsigned char lds_raw[];
    LAS unsigned char* lds = (LAS unsigned char*)lds_raw;
    const int wave_s = __builtin_amdgcn_readfirstlane((int)threadIdx.x >> 6);
    { PH_BEGIN PH_GRP phase_x0(A->in[0], (bf16_t*)(ws + O_HB), (ssq_t*)(ws + O_SS), tid, wave, lane, gr); }
    { PH_BEGIN phase_convert(A, 0, lds, tid, wave, lane, G); }
    cg::this_grid().sync();
    CHIP_BAR(1)
    int bk = 0;
    layer_body<0>(lds, wave_s, bk);
    CHIP_BAR(2)
    { PH_BEGIN phase_convert(A, 1, lds, tid, wave, lane, G); }
    CHIP_BAR(3)
    layer_body<1>(lds, wave_s, bk);
}

extern "C" void kernel_launch(void* const* d_in, const int* in_sizes, int n_in, void* d_out, int out_size, void* d_ws, size_t ws_size, hipStream_t stream) {
    static int grid = 0;
    if (grid == 0) {
        if (n_in != 29 || out_size != T * DM || ws_size < O_END2) { fprintf(stderr, "kernel_launch: unexpected shapes (n_in %d, out %d, ws %zu, need %zu)\n", n_in, out_size, ws_size, (size_t)O_END2); grid = -1; return; }
        int dev = 0, cus = 0, per_cu = 0;
        if (hipGetDevice(&dev) != hipSuccess || hipDeviceGetAttribute(&cus, hipDeviceAttributeMultiprocessorCount, dev) != hipSuccess) { grid = -1; return; }
        if (hipFuncSetAttribute((const void*)hybrid_fwd, hipFuncAttributeMaxDynamicSharedMemorySize, LDS_BYTES) != hipSuccess) { fprintf(stderr, "kernel_launch: hipFuncSetAttribute failed\n"); grid = -1; return; }
        if (hipOccupancyMaxActiveBlocksPerMultiprocessor(&per_cu, (const void*)hybrid_fwd, NTHREADS, LDS_BYTES) != hipSuccess || per_cu < 1) { fprintf(stderr, "kernel_launch: occupancy query says %d blocks per CU\n", per_cu); per_cu = 1; }
        (void)hipGetLastError();
        grid = cus;
        if (grid != 256) { fprintf(stderr, "kernel_launch: built for 256 CUs (8 batch groups of 32 workgroups), found %d\n", cus); grid = -1; return; }
    }
    if (grid < 0) return;
    if (hipMemsetAsync((char*)d_ws + O_BAR, 0, 4096, stream) != hipSuccess) { fprintf(stderr, "kernel_launch: hipMemsetAsync failed\n"); return; }
    Args a{};
    for (int i = 0; i < 29; ++i) a.in[i] = (const float*)d_in[i];
    a.out = (float*)d_out; a.ws = (unsigned char*)d_ws;
    void* args[] = {&a};
    hipError_t e = hipLaunchCooperativeKernel((const void*)hybrid_fwd, dim3(grid), dim3(NTHREADS), args, LDS_BYTES, stream);
    if (e != hipSuccess) fprintf(stderr, "kernel_launch: cooperative launch failed: %s (grid %d)\n", hipGetErrorString(e), grid);
}
```
